# Optimizing an MI355X kernel written in HIP

```python
import jax, jax.numpy as jnp
from jax import lax
import numpy as np


D_MODEL = 2048
BATCH = 2
SEQ = 4096
DEPTH = 4

CHUNK = 64
Q_BLOCK = 128
EPS = 1e-6
ROPE_BASE = 10000.0

D_MIX = D_MODEL
MLA_HEADS = 8
MLA_NOPE = 128
MLA_ROPE = 64
MLA_QK = MLA_NOPE + MLA_ROPE
MLA_V = 128
Q_LORA = 512
KV_LORA = 256
MLA_WIDTH = MLA_HEADS * MLA_V
SB_HEADS = 8
SB_DIM = 128
SB_WIDTH = SB_HEADS * SB_DIM
IN_COLS = Q_LORA + KV_LORA + MLA_ROPE + 3 * SB_WIDTH

N_EXPERTS = 16
N_GROUPS = 4
EXPERTS_PER_GROUP = N_EXPERTS // N_GROUPS
TOP_K = 2
D_EXPERT = 512
MOE_BLOCK = 128

kernel_name = 'hybrid_mla_stickbreak_grouped_moe_adaln'


def rms_norm(x, g):
    xf = x.astype(jnp.float32)
    y = xf * lax.rsqrt(jnp.mean(xf * xf, axis=-1, keepdims=True) + EPS)
    return (y * g.astype(jnp.float32)).astype(x.dtype)


def modulate(h, shift, scale):
    return h * (1 + scale[:, None, :]) + shift[:, None, :]


def rope_tables(seq, dim):
    inv = 1.0 / (ROPE_BASE ** (jnp.arange(0, dim, 2, dtype=jnp.float32) / dim))
    ang = jnp.arange(seq, dtype=jnp.float32)[:, None] * inv[None, :]
    return jnp.cos(ang), jnp.sin(ang)


def apply_rope(x, cos, sin):
    x1, x2 = jnp.split(x, 2, axis=-1)
    c = cos[:, None, :].astype(x.dtype)
    s = sin[:, None, :].astype(x.dtype)
    return jnp.concatenate([x1 * c - x2 * s, x1 * s + x2 * c], axis=-1)


def to_query_blocks(q):
    B, S, H, d = q.shape
    return q.reshape(B, S // Q_BLOCK, Q_BLOCK, H, d).transpose(1, 0, 3, 2, 4)


def from_query_blocks(o):
    nb, B, Qb, H, d = o.shape
    return o.transpose(1, 0, 2, 3, 4).reshape(B, nb * Qb, H * d)


def mla_attention(cq, ckv, krope, q_lora_g, kv_lora_g, w_uq, w_ukv, q_head_g, k_head_g, cos, sin):
    B, S, _ = cq.shape
    q = (rms_norm(cq, q_lora_g) @ w_uq).reshape(B, S, MLA_HEADS, MLA_QK)
    kv = (rms_norm(ckv, kv_lora_g) @ w_ukv).reshape(B, S, MLA_HEADS, MLA_NOPE + MLA_V)
    k_nope, v = kv[..., :MLA_NOPE], kv[..., MLA_NOPE:]
    k_rope = jnp.broadcast_to(krope[:, :, None, :], (B, S, MLA_HEADS, MLA_ROPE))
    k = jnp.concatenate([k_nope, k_rope], axis=-1)
    q = rms_norm(q, q_head_g)
    k = rms_norm(k, k_head_g)
    q = jnp.concatenate([q[..., :MLA_NOPE], apply_rope(q[..., MLA_NOPE:], cos, sin)], axis=-1)
    k = jnp.concatenate([k[..., :MLA_NOPE], apply_rope(k[..., MLA_NOPE:], cos, sin)], axis=-1)
    scale = MLA_QK ** -0.5
    key_chunk = jnp.arange(S) // CHUNK

    def block(args):
        qi, b_idx = args
        s = jnp.einsum('bhqd,bshd->bhqs', qi, k).astype(jnp.float32) * scale
        q_chunk = (b_idx * Q_BLOCK + jnp.arange(Q_BLOCK)) // CHUNK
        mask = key_chunk[None, :] <= q_chunk[:, None]
        p = jax.nn.softmax(jnp.where(mask, s, -jnp.inf), axis=-1).astype(v.dtype)
        return jnp.einsum('bhqs,bshd->bqhd', p, v)

    qb = to_query_blocks(q)
    o = lax.map(block, (qb, jnp.arange(qb.shape[0])))
    return from_query_blocks(o)


def stick_breaking_attention(q, k, v):
    B, S, H, d = q.shape
    scale = d ** -0.5
    key_pos = jnp.arange(S)

    def block(args):
        qi, b_idx = args
        z = jnp.einsum('bhqd,bshd->bhqs', qi, k).astype(jnp.float32) * scale
        t = b_idx * Q_BLOCK + jnp.arange(Q_BLOCK)
        mask = key_pos[None, :] < t[:, None]
        log_stay = jnp.where(mask, jax.nn.log_sigmoid(-z), 0.0)
        after = lax.cumsum(log_stay, axis=3, reverse=True) - log_stay
        a = jnp.where(mask, jnp.exp(jax.nn.log_sigmoid(z) + after), 0.0)
        return jnp.einsum('bhqs,bshd->bqhd', a.astype(v.dtype), v)

    qb = to_query_blocks(q)
    o = lax.map(block, (qb, jnp.arange(qb.shape[0])))
    return from_query_blocks(o)


def grouped_route(h, router_w, router_b):
    T = h.shape[0]
    scores = jax.nn.sigmoid((h @ router_w).astype(jnp.float32))
    sel = (scores + router_b.astype(jnp.float32)).reshape(T, N_GROUPS, EXPERTS_PER_GROUP)
    group_score = lax.top_k(sel, TOP_K)[0].sum(-1)
    g = jnp.argmax(group_score, axis=-1)
    in_group = jnp.take_along_axis(sel, g[:, None, None], axis=1)[:, 0]
    _, local = lax.top_k(in_group, TOP_K)
    idx = g[:, None] * EXPERTS_PER_GROUP + local
    w = jnp.take_along_axis(scores, idx, axis=1)
    w = w / jnp.sum(w, axis=-1, keepdims=True)
    return idx, w


def moe_ffn(h, idx, w, w_gate, w_up, w_down):
    T, D = h.shape
    A = T * TOP_K
    flat_e = idx.reshape(A)
    order = jnp.argsort(flat_e)
    e_sorted = flat_e[order]
    tok_sorted = order // TOP_K
    w_sorted = w.reshape(A)[order]
    counts = jnp.bincount(flat_e, length=N_EXPERTS)
    padded = (counts + MOE_BLOCK - 1) // MOE_BLOCK * MOE_BLOCK
    pad_end = jnp.cumsum(padded)
    pad_start = pad_end - padded
    start = jnp.cumsum(counts) - counts
    dest = pad_start[e_sorted] + jnp.arange(A) - start[e_sorted]
    n_blocks = -(-A // MOE_BLOCK) + N_EXPERTS
    rows = n_blocks * MOE_BLOCK
    row_tok = jnp.full((rows,), T, dtype=jnp.int32).at[dest].set(tok_sorted.astype(jnp.int32))
    block_e = jnp.minimum(jnp.searchsorted(pad_end, jnp.arange(n_blocks) * MOE_BLOCK, side='right'), N_EXPERTS - 1)
    h_pad = jnp.concatenate([h, jnp.zeros((1, D), h.dtype)], axis=0)

    def block(args):
        toks, e = args
        xb = h_pad[toks]
        a = jax.nn.silu(xb @ w_gate[e]) * (xb @ w_up[e])
        return a @ w_down[e]

    y = lax.map(block, (row_tok.reshape(n_blocks, MOE_BLOCK), block_e)).reshape(rows, D)
    contrib = y[dest] * w_sorted[:, None].astype(h.dtype)
    return jnp.zeros((T, D), h.dtype).at[tok_sorted].add(contrib)


def setup_inputs(seed: int = 0) -> dict:
    key = jax.random.key(seed)
    ks = jax.random.split(key, 24)
    nrm = lambda k, shape, s: jax.random.normal(k, shape, jnp.float32) * s
    gain = lambda k, shape: 1.0 + 0.02 * jax.random.normal(k, shape, jnp.float32)
    return {
        'x': nrm(ks[0], (BATCH, SEQ, D_MODEL), 1.0),
        'c': nrm(ks[1], (BATCH, D_MODEL), 1.0),
        'norm1_g': gain(ks[2], (DEPTH, D_MODEL)),
        'norm2_g': gain(ks[3], (DEPTH, D_MODEL)),
        'w_ada': nrm(ks[4], (DEPTH, D_MODEL, 6 * D_MODEL), 0.5 * D_MODEL ** -0.5),
        'b_ada': nrm(ks[5], (DEPTH, 6 * D_MODEL), 0.02),
        'w_in': nrm(ks[6], (DEPTH, D_MODEL, IN_COLS), D_MODEL ** -0.5),
        'q_lora_g': gain(ks[7], (DEPTH, Q_LORA)),
        'kv_lora_g': gain(ks[8], (DEPTH, KV_LORA)),
        'w_uq': nrm(ks[9], (DEPTH, Q_LORA, MLA_HEADS * MLA_QK), Q_LORA ** -0.5),
        'w_ukv': nrm(ks[10], (DEPTH, KV_LORA, MLA_HEADS * (MLA_NOPE + MLA_V)), KV_LORA ** -0.5),
        'q_head_g': gain(ks[11], (DEPTH, MLA_QK)),
        'k_head_g': gain(ks[12], (DEPTH, MLA_QK)),
        'mla_out_g': gain(ks[13], (DEPTH, MLA_WIDTH)),
        'sb_out_g': gain(ks[14], (DEPTH, SB_WIDTH)),
        'w_o': nrm(ks[15], (DEPTH, D_MIX, D_MODEL), D_MIX ** -0.5),
        'router_w': nrm(ks[16], (D_MODEL, N_EXPERTS), D_MODEL ** -0.5),
        'router_b': nrm(ks[17], (N_EXPERTS,), 0.01),
        'w_gate': nrm(ks[18], (DEPTH, N_EXPERTS, D_MODEL, D_EXPERT), D_MODEL ** -0.5),
        'w_up': nrm(ks[19], (DEPTH, N_EXPERTS, D_MODEL, D_EXPERT), D_MODEL ** -0.5),
        'w_down': nrm(ks[20], (DEPTH, N_EXPERTS, D_EXPERT, D_MODEL), D_EXPERT ** -0.5),
    }


def reference(x, c, norm1_g, norm2_g, w_ada, b_ada, w_in, q_lora_g, kv_lora_g, w_uq, w_ukv,
              q_head_g, k_head_g, mla_out_g, sb_out_g, w_o, router_w, router_b,
              w_gate, w_up, w_down):
    B, S, D = x.shape
    T = B * S
    cos, sin = rope_tables(S, MLA_ROPE)
    c_act = jax.nn.silu(c)
    splits = [Q_LORA, Q_LORA + KV_LORA, Q_LORA + KV_LORA + MLA_ROPE,
              Q_LORA + KV_LORA + MLA_ROPE + SB_WIDTH, Q_LORA + KV_LORA + MLA_ROPE + 2 * SB_WIDTH]
    for l in range(DEPTH):
        mod = c_act @ w_ada[l] + b_ada[l]
        shift_a, scale_a, gate_a, shift_f, scale_f, gate_f = jnp.split(mod, 6, axis=-1)

        h = modulate(rms_norm(x, norm1_g[l]), shift_a, scale_a)
        proj = h @ w_in[l]
        cq, ckv, krope, sq, sk, sv = jnp.split(proj, splits, axis=-1)
        o_mla = mla_attention(cq, ckv, krope, q_lora_g[l], kv_lora_g[l], w_uq[l], w_ukv[l],
                              q_head_g[l], k_head_g[l], cos, sin)
        o_sb = stick_breaking_attention(sq.reshape(B, S, SB_HEADS, SB_DIM),
                                        sk.reshape(B, S, SB_HEADS, SB_DIM),
                                        sv.reshape(B, S, SB_HEADS, SB_DIM))
        o = jnp.concatenate([rms_norm(o_mla, mla_out_g[l]), rms_norm(o_sb, sb_out_g[l])], axis=-1)
        x = x + gate_a[:, None, :] * (o @ w_o[l])

        h2 = modulate(rms_norm(x, norm2_g[l]), shift_f, scale_f).reshape(T, D)
        idx, w = grouped_route(h2, router_w, router_b)
        y = moe_ffn(h2, idx, w, w_gate[l], w_up[l], w_down[l]).reshape(B, S, D)
        x = x + gate_f[:, None, :] * y
    return x
```

```cpp
#include <hip/hip_runtime.h>
#include <cstdio>
#include <cstdint>

#ifndef MK_ONE_LAUNCH
#define MK_ONE_LAUNCH 1
#endif
#ifndef MK_SIMPLE_GEMM
#define MK_SIMPLE_GEMM 0
#endif
#ifndef MK_NAIVE_ATTN
#define MK_NAIVE_ATTN 0
#endif

#ifndef MK_ATT_REP_MLA
#define MK_ATT_REP_MLA 1
#endif
#ifndef MK_ATT_REP_SB
#define MK_ATT_REP_SB 1
#endif
#define LAS __attribute__((address_space(3)))
#define GAS __attribute__((address_space(1)))
typedef unsigned short bf16_t;
typedef short bf16x8 __attribute__((ext_vector_type(8)));
typedef short s16x4 __attribute__((ext_vector_type(4)));
typedef float f32x4 __attribute__((ext_vector_type(4)));
typedef float f32x2 __attribute__((ext_vector_type(2)));
typedef float f32x16 __attribute__((ext_vector_type(16)));
typedef unsigned u32x4 __attribute__((ext_vector_type(4)));
typedef unsigned u32x2 __attribute__((ext_vector_type(2)));

constexpr int D = 2048, NB = 2, SEQ = 4096, T = NB * SEQ, DEPTH = 4;
constexpr int QL = 512, KVL = 256, ROPE = 64, NOPE = 128, QK = 192, DV = 128, NH = 8;
constexpr int INC = 3904, INP = 4096;
constexpr int NE = 16, DE = 512;
constexpr int C_CQ = 0, C_CKV = 512, C_KR = 768, C_SQ = 832, C_SK = 1856, C_SV = 2880;
constexpr int MAXROWS = 20480;
constexpr float EPS = 1e-6f;
constexpr float QSCALE_MLA = 0.10411754627697264f;
constexpr float QSCALE_SB = 0.12751743082459868f;
constexpr int NWAVES = 8, NTHR = 512;
constexpr int LDS_BYTES = 147456;
constexpr int LDS_X = 131072;

__device__ const float ROPE_INV[32] = {
1.000000000e+00f,7.498942018e-01f,5.623413324e-01f,4.216965139e-01f,3.162277639e-01f,2.371373922e-01f,1.778279394e-01f,1.333521456e-01f,1.000000015e-01f,7.498941571e-02f,5.623412877e-02f,4.216964915e-02f,3.162277862e-02f,2.371373586e-02f,1.778279431e-02f,1.333521493e-02f,9.999999776e-03f,7.498942316e-03f,5.623413250e-03f,4.216964822e-03f,3.162277862e-03f,2.371373819e-03f,1.778279431e-03f,1.333521446e-03f,1.000000047e-03f,7.498941850e-04f,5.623413017e-04f,4.216965463e-04f,3.162277862e-04f,2.371373848e-04f,1.778279402e-04f,1.333521504e-04f};

constexpr size_t MiB = 1u << 20;
constexpr size_t WS_CTL = 0, CTL_BYTES = 1 * MiB;
constexpr size_t WS_MODP = 1 * MiB;
constexpr size_t WS_MOD = 4 * MiB;
constexpr size_t WS_ROPE = 5 * MiB;
constexpr size_t WS_SLOT = 6 * MiB;
constexpr size_t WS_TOK = 7 * MiB;
constexpr size_t WS_WIN = 8 * MiB, WS_WUQ = 72 * MiB, WS_WUKV = 78 * MiB, WS_WO = 82 * MiB, WS_WGU = 114 * MiB, WS_WDN = 370 * MiB;
constexpr size_t WS_H = 498 * MiB, WS_PROJ = 530 * MiB, WS_CQN = 594 * MiB, WS_CKVN = 602 * MiB, WS_QRAW = 606 * MiB, WS_KVRAW = 630 * MiB;
constexpr size_t WS_QF = 662 * MiB, WS_KF = 686 * MiB, WS_OATT = 710 * MiB, WS_OCAT = 742 * MiB, WS_ACT = 774 * MiB, WS_Y = 794 * MiB, WS_XB = 874 * MiB, WS_END = 906 * MiB;
constexpr size_t WS_MOD2 = WS_MOD + 512 * 1024;
constexpr size_t WS_RWT = WS_CKVN;
constexpr int CW_BAR = 4096;
constexpr int CW_CVQ = 61440;
constexpr int CW_GUF = 49152;
constexpr int CW_FLG = 32768;
constexpr int CW_CNT = 16384;

__device__ __forceinline__ float bf2f(unsigned b) { return __uint_as_float(b << 16); }
__device__ __forceinline__ float bflo(unsigned w) { return __uint_as_float(w << 16); }
__device__ __forceinline__ float bfhi(unsigned w) { return __uint_as_float(w & 0xffff0000u); }
__device__ __forceinline__ unsigned cvtpk(float lo, float hi) { unsigned r; asm volatile("v_cvt_pk_bf16_f32 %0, %1, %2" : "=v"(r) : "v"(lo), "v"(hi)); return r; }
__device__ __forceinline__ bf16_t f2bf(float f) { return (bf16_t)(cvtpk(f, 0.f) & 0xffffu); }
template <int M> __device__ __forceinline__ float lane_xor(float v) { return __int_as_float(__builtin_amdgcn_ds_swizzle(__float_as_int(v), (M << 10) | 0x1f)); }
__device__ __forceinline__ float half_sum(float v) { auto rr = __builtin_amdgcn_permlane32_swap(__float_as_uint(v), __float_as_uint(v), false, false); return __uint_as_float(rr[0]) + __uint_as_float(rr[1]); }
__device__ __forceinline__ float half_max(float v) { auto rr = __builtin_amdgcn_permlane32_swap(__float_as_uint(v), __float_as_uint(v), false, false); return fmaxf(__uint_as_float(rr[0]), __uint_as_float(rr[1])); }
template <int CTRL> __device__ __forceinline__ float dpp_mov(float v) { return __int_as_float(__builtin_amdgcn_update_dpp(0, __float_as_int(v), CTRL, 0xf, 0xf, true)); }
__device__ __forceinline__ float quarter_sum(float v) { auto rr = __builtin_amdgcn_permlane16_swap(__float_as_uint(v), __float_as_uint(v), false, false); return __uint_as_float(rr[0]) + __uint_as_float(rr[1]); }
__device__ __forceinline__ float wave_sum_dpp(float v) {
    v += dpp_mov<0x128>(v); v += dpp_mov<0x124>(v); v += dpp_mov<0x122>(v); v += dpp_mov<0x121>(v);
    return half_sum(quarter_sum(v));
}
__device__ __forceinline__ float wave_sum(float v) { return wave_sum_dpp(v); }
__device__ __forceinline__ float wave_max(float v) {
    v = fmaxf(v, lane_xor<1>(v)); v = fmaxf(v, lane_xor<2>(v)); v = fmaxf(v, lane_xor<4>(v)); v = fmaxf(v, lane_xor<8>(v)); v = fmaxf(v, lane_xor<16>(v));
    return half_max(v);
}

__device__ __forceinline__ int lane_id_volatile() { int l; asm volatile("v_mbcnt_lo_u32_b32 %0, -1, 0\n\tv_mbcnt_hi_u32_b32 %0, -1, %0" : "=v"(l)); return l; }
__device__ __forceinline__ int sgpr_launder(int v) { asm volatile("" : "+s"(v)); return v; }
#define XB_TMO      128
#define XB_XCNT(j)  (256  + 64 * (j))
#define XB_XSUB(j)  (1280 + 64 * (j))
#define XB_XGEN(j)  (2304 + 64 * (j))
#define XB_TOP      3328
#define XB_TOPGEN   3392
#define XCD_BAR_WORDS 3456
#define XB_SPIN_CAP (1u << 18)
__device__ __forceinline__ unsigned xb_ld(unsigned* p)              { return __hip_atomic_load(p, __ATOMIC_RELAXED, __HIP_MEMORY_SCOPE_AGENT); }
__device__ __forceinline__ unsigned xb_add(unsigned* p, unsigned v) { return __hip_atomic_fetch_add(p, v, __ATOMIC_RELAXED, __HIP_MEMORY_SCOPE_AGENT); }
__device__ __forceinline__ unsigned xb_xcc_id() { return (unsigned)__builtin_amdgcn_s_getreg((3 << 11) | 20) & 0xFu; }
#define XB_SPIN(cond, bar) do { unsigned _sp = 0; while (cond) { __builtin_amdgcn_s_sleep(1); \
    if ((++_sp & 255u) == 0u) { if (xb_ld(&(bar)[XB_TMO])) break; if (_sp > XB_SPIN_CAP) { atomicAdd(&(bar)[XB_TMO], 1u); break; } } } } while (0)
struct XcdBarrier { unsigned* bar; unsigned x; volatile LAS unsigned* st; };
__device__ __forceinline__ XcdBarrier xcd_barrier_post(unsigned* bar, volatile LAS unsigned* st, const bool t0) {
    XcdBarrier b; b.bar = bar; b.x = xb_xcc_id(); b.st = st;
    if (t0) (void)xb_add(&bar[XB_XCNT(b.x)], 1u);
    return b;
}
__device__ __forceinline__ void xcd_barrier_complete(unsigned* bar, unsigned x, unsigned& nloc, unsigned& nx) {
    const unsigned G = gridDim.x * gridDim.y * gridDim.z;
    unsigned sum, cnt, mine, sp = 0u;
    for (;;) {
        sum = 0u; cnt = 0u; mine = 0u;
#pragma unroll
        for (unsigned j = 0; j < 16; ++j) { const unsigned c = xb_ld(&bar[XB_XCNT(j)]); sum += c; cnt += (c > 0u) ? 1u : 0u; mine = (j == x) ? c : mine; }
        if (sum == G) break;
        __builtin_amdgcn_s_sleep(1);
        if ((++sp & 255u) == 0u) { if (xb_ld(&bar[XB_TMO])) break; if (sp > XB_SPIN_CAP) { atomicAdd(&bar[XB_TMO], 1u); break; } }
    }
    nloc = mine > 0u ? mine : 1u; nx = cnt > 0u ? cnt : 1u;
}
__device__ __forceinline__ void xcd_barrier(const XcdBarrier& b, const bool t0, const int mode = 0) {
    if (mode == 2) {
        if (t0) { unsigned* bar = b.bar; const unsigned gen = b.st[2];
            XB_SPIN(xb_ld(&bar[XB_XGEN(b.x)]) == gen, bar);
            __builtin_amdgcn_fence(__ATOMIC_ACQUIRE, "agent");
            asm volatile("s_waitcnt vmcnt(0)" ::: "memory"); }
        __syncthreads();
        return; }
    asm volatile("s_waitcnt vmcnt(0)" ::: "memory");
    __syncthreads();
    if (t0) {
        unsigned* bar = b.bar;
        __builtin_amdgcn_s_waitcnt(0);
        unsigned nloc = b.st[0], nx = b.st[1];
        if (nloc == 0u) { xcd_barrier_complete(bar, b.x, nloc, nx); b.st[0] = nloc; b.st[1] = nx; }
        const unsigned old = xb_add(&bar[XB_XSUB(b.x)], 1u);
        const unsigned gen = old / nloc;
        if (old + 1u == (gen + 1u) * nloc) {
            __builtin_amdgcn_fence(__ATOMIC_RELEASE, "agent");
            asm volatile("s_waitcnt vmcnt(0)" ::: "memory");
            const unsigned og = xb_add(&bar[XB_TOP], 1u);
            const unsigned tg = og / nx;
            if (og + 1u != (tg + 1u) * nx) XB_SPIN(xb_ld(&bar[XB_TOP]) < (tg + 1u) * nx, bar);
            xb_add(&bar[XB_XGEN(b.x)], 1u);
            __builtin_amdgcn_fence(__ATOMIC_ACQUIRE, "agent");
            asm volatile("s_waitcnt vmcnt(0)" ::: "memory");
        } else if (mode == 1) { b.st[2] = gen; b.st[3] = 0u;
        } else {
            asm volatile("buffer_inv sc1" ::: "memory");
            XB_SPIN(xb_ld(&bar[XB_XGEN(b.x)]) == gen, bar);
            asm volatile("s_waitcnt vmcnt(0)" ::: "memory");
        }
        if (mode == 1 && old + 1u == (gen + 1u) * nloc) { b.st[2] = gen; b.st[3] = 1u; }
    }
    __syncthreads();
}

struct Params {
    const float *x, *c, *norm1_g, *norm2_g, *w_ada, *b_ada, *w_in, *q_lora_g, *kv_lora_g, *w_uq, *w_ukv, *q_head_g, *k_head_g, *mla_out_g, *sb_out_g, *w_o,
                *router_w, *router_b, *w_gate, *w_up, *w_down;
    float* out; unsigned char* ws;
    int ph_lo, ph_hi;
};
struct Ctx {
    LAS unsigned char* lds;
    int tid, lane, wave, G, blk, gw, ngw;
};

struct GUnit {
    int arow0;
    const int* amap;
    int avalid;
    const bf16_t* Bt;
    int orow0, ocol0;
    int aux;
};
struct GemmA { const bf16_t* A; int lda; int K; };

struct RegSched {
    static constexpr bool GATHER = false;
    int nM, nN, nwg, G, c, K; const bf16_t* Bt;
    __device__ void init(int M, int N, int K_, const bf16_t* Bt_, int G_, int c_) { nM = M / 256; nN = N / 256; nwg = nM * nN; G = G_; c = c_; K = K_; Bt = Bt_; }
    __device__ __forceinline__ bool next(int i, GUnit& u) const {
        const long L = (long)i * G + c; if (L >= nwg) return false;
        int wgid = (int)L; { const int q = nwg / 8, r = nwg % 8, xcd = wgid % 8, off = wgid / 8; wgid = (xcd < r ? xcd * (q + 1) : r * (q + 1) + (xcd - r) * q) + off; }
        const int nig = 8 * nN, gid = wgid / nig, fm = gid * 8, gsz = (nM - fm) < 8 ? (nM - fm) : 8;
        const int pm = fm + ((wgid % nig) % gsz), pn = (wgid % nig) / gsz;
        u.arow0 = pm * 256; u.amap = nullptr; u.avalid = 256; u.Bt = Bt + (size_t)pn * 256 * K; u.orow0 = pm * 256; u.ocol0 = pn * 256; u.aux = 0;
        return true;
    }
};
struct MoeSched {
    static constexpr bool GATHER = true;
    const LAS int* cnt;
    int npn, G, c, K; const bf16_t* W; size_t wstride; const int* tok;
    int lo, hi;
    __device__ __forceinline__ bool next(int i, GUnit& u) const {
        const int L = lo + i * G + c; if (L < lo || L >= hi) return false;
        const int tile = L / npn, pn = L - tile * npn;
        int tb = 0, rb = 0, e = -1, rt = 0, ce = 0;
#pragma unroll 1
        for (int k = 0; k < NE; ++k) { const int ck = cnt[k], nt = (ck + 255) >> 8; if (e < 0 && tile < tb + nt) { e = k; rt = tile - tb; ce = ck; } if (e < 0) { tb += nt; rb += nt * 256; } }
        if (e < 0) return false;
        u.arow0 = rb + rt * 256; u.amap = tok ? tok + e * T + rt * 256 : nullptr; u.avalid = (ce - rt * 256) < 256 ? (ce - rt * 256) : 256;
        u.Bt = W + (size_t)e * wstride + (size_t)pn * 256 * K; u.orow0 = rb + rt * 256; u.ocol0 = pn * 256; u.aux = e;
        return true;
    }
};

struct EpiStoreBf16 {
    static constexpr bool PERM = true, ROWSS = false, RESC = false, TABPRE = false, RESID = false, KVK = false;
    bf16_t* O; int ldc;
    __device__ __forceinline__ float rowpre(const GUnit&, int) const { return 1.f; }
    __device__ __forceinline__ void rowss(const GUnit&, int, int, float) const {}
    __device__ __forceinline__ void store8(const GUnit& u, int r, int c, f32x4 v0, f32x4 v1) const {
        u32x4 w; w.x = cvtpk(v0[0], v0[1]); w.y = cvtpk(v0[2], v0[3]); w.z = cvtpk(v1[0], v1[1]); w.w = cvtpk(v1[2], v1[3]);
        *(GAS u32x4*)(O + (size_t)(u.orow0 + r) * ldc + u.ocol0 + c) = w;
    }
};
struct EpiInProj {
    static constexpr bool PERM = true, ROWSS = true, RESC = false, TABPRE = false, RESID = false, KVK = false;
    bf16_t* O; float* SS;
    __device__ __forceinline__ float rowpre(const GUnit&, int) const { return 1.f; }
    __device__ __forceinline__ void store8(const GUnit& u, int r, int c, f32x4 v0, f32x4 v1) const {
        u32x4 w; w.x = cvtpk(v0[0], v0[1]); w.y = cvtpk(v0[2], v0[3]); w.z = cvtpk(v1[0], v1[1]); w.w = cvtpk(v1[2], v1[3]);
        *(GAS u32x4*)(O + (size_t)(u.orow0 + r) * INP + u.ocol0 + c) = w;
    }
    __device__ __forceinline__ void rowss(const GUnit& u, int r, int wc, float ss) const { if (u.ocol0 < 768) SS[(size_t)(u.orow0 + r) * 12 + (u.ocol0 >> 8) * 4 + wc] = ss; }
};
struct EpiScaleBf16 {
    static constexpr bool PERM = true, ROWSS = false, RESC = false, TABPRE = true, RESID = false, KVK = false;
    bf16_t* O; int ldc; const float* SS; int p0, np; float invn;
    __device__ __forceinline__ float rowpre(const GUnit& u, int r) const { const GAS float* q = (const GAS float*)(SS + (size_t)(u.orow0 + r) * 12 + p0); float s = 0.f; for (int i = 0; i < np; ++i) s += q[i]; return rsqrtf(s * invn + EPS); }
    __device__ __forceinline__ void rowss(const GUnit&, int, int, float) const {}
    __device__ __forceinline__ void rs_table(const GUnit& u, int tid, LAS float* tab) const {
        if (tid < 256) { const GAS float* q = (const GAS float*)(SS + (size_t)(u.orow0 + tid) * 12 + p0); float sm = 0.f; for (int i = 0; i < np; ++i) sm += q[i]; tab[tid] = rsqrtf(sm * invn + EPS); } }
    __device__ __forceinline__ void store8(const GUnit& u, int r, int c, f32x4 v0, f32x4 v1) const {
        u32x4 w; w.x = cvtpk(v0[0], v0[1]); w.y = cvtpk(v0[2], v0[3]); w.z = cvtpk(v1[0], v1[1]); w.w = cvtpk(v1[2], v1[3]);
        *(GAS u32x4*)(O + (size_t)(u.orow0 + r) * ldc + u.ocol0 + c) = w;
    }
};
struct EpiKV {
    static constexpr bool PERM = true, ROWSS = false, RESC = false, TABPRE = true, RESID = false, KVK = true;
    unsigned char* ws; const float* kg;
    __device__ __forceinline__ float rowpre(const GUnit&, int) const { return 1.f; }
    __device__ __forceinline__ void rowss(const GUnit&, int, int, float) const {}
    __device__ __forceinline__ void rs_table(const GUnit& u, int tid, LAS float* tab) const {
        if (tid < 256) { const GAS float* q = (const GAS float*)((const float*)(ws + WS_CQN) + (size_t)(u.orow0 + tid) * 12 + 8); tab[tid] = rsqrtf(((q[0] + q[1]) + (q[2] + q[3])) * (1.f / KVL) + EPS); } }
};
struct EpiResid {
    static constexpr bool PERM = true, ROWSS = false, TABPRE = false, KVK = false;
    __device__ __forceinline__ float rowpre(const GUnit&, int) const { return 1.f; }
    __device__ __forceinline__ void rowss(const GUnit&, int, int, float) const {}
    const float* xin; float* xout; const float* gate; bf16_t* xb; const float* oss; bf16_t* xbo;
    static constexpr bool RESID = true, RESC = true;
    __device__ __forceinline__ void rs_table(const GUnit& u, int tid, LAS float* tab) const {
        if (tid < 256) { const GAS f32x4* q = (const GAS f32x4*)(oss + (size_t)(u.orow0 + tid) * 16); const f32x4 a = q[0], b = q[1], c = q[2], d = q[3];
            const float rm = rsqrtf((((a[0] + a[1]) + (a[2] + a[3])) + ((b[0] + b[1]) + (b[2] + b[3]))) * (1.f / 1024) + EPS), rsb = rsqrtf((((c[0] + c[1]) + (c[2] + c[3])) + ((d[0] + d[1]) + (d[2] + d[3]))) * (1.f / 1024) + EPS);
            tab[tid] = rm * __builtin_amdgcn_rcpf(rsb); tab[256 + tid] = rsb; }
    }
    __device__ __forceinline__ void rstds8(const GUnit& u, int wr, int fr, int fq, float (&rm)[2][4], float (&rsb)[2][4]) const {
        f32x4 q[2][4];
#pragma unroll
        for (int ai = 0; ai < 2; ++ai)
#pragma unroll
            for (int m = 0; m < 4; ++m) q[ai][m] = *(const GAS f32x4*)(oss + (size_t)(u.orow0 + ai * 128 + wr * 64 + m * 16 + fr) * 16 + 4 * fq);
#pragma unroll
        for (int ai = 0; ai < 2; ++ai)
#pragma unroll
            for (int m = 0; m < 4; ++m) { float sv = (q[ai][m][0] + q[ai][m][1]) + (q[ai][m][2] + q[ai][m][3]); sv += lane_xor<16>(sv);
                auto rr = __builtin_amdgcn_permlane32_swap(__float_as_uint(sv), __float_as_uint(sv), false, false);
                rm[ai][m] = rsqrtf(__uint_as_float(rr[0]) * (1.f / 1024) + EPS); rsb[ai][m] = rsqrtf(__uint_as_float(rr[1]) * (1.f / 1024) + EPS); }
    }
    __device__ __forceinline__ f32x4 gate4(const GUnit& u, int c) const { return *(const GAS f32x4*)(gate + (size_t)(u.orow0 >> 12) * 12288 + u.ocol0 + c); }
    __device__ __forceinline__ f32x4 load4(const GUnit& u, int r, int c) const { const u32x2 w = *(const GAS u32x2*)(xb + (size_t)(u.orow0 + r) * D + u.ocol0 + c); return (f32x4){bflo(w.x), bfhi(w.x), bflo(w.y), bfhi(w.y)}; }
    __device__ __forceinline__ u32x4 load8(const GUnit& u, int r, int c) const { return *(const GAS u32x4*)(xb + (size_t)(u.orow0 + r) * D + u.ocol0 + c); }
    __device__ __forceinline__ void put8(const GUnit& u, int r, int c, u32x4 w) const { *(GAS u32x4*)(xbo + (size_t)(u.orow0 + r) * D + u.ocol0 + c) = w; }
    __device__ __forceinline__ void put4(const GUnit& u, int r, int c, f32x4 v) const { u32x2 w; w.x = cvtpk(v[0], v[1]); w.y = cvtpk(v[2], v[3]); *(GAS u32x2*)(xb + (size_t)(u.orow0 + r) * D + u.ocol0 + c) = w; }
    __device__ __forceinline__ void store4(const GUnit& u, int r, int c, f32x4 v) const {
        const int row = u.orow0 + r, col = u.ocol0 + c, b = row >> 12;
        const f32x4 g = *(const GAS f32x4*)(gate + (size_t)b * 12288 + col);
        const f32x4 xi = *(const GAS f32x4*)(xin + (size_t)row * D + col);
        *(GAS f32x4*)(xout + (size_t)row * D + col) = xi + g * v;
    }
};
struct EpiGU {
    static constexpr bool PERM = true, ROWSS = false, RESC = false, TABPRE = false, RESID = false, KVK = false;
    __device__ __forceinline__ float rowpre(const GUnit&, int) const { return 1.f; }
    __device__ __forceinline__ void rowss(const GUnit&, int, int, float) const {}
    bf16_t* act;
    __device__ __forceinline__ float su(float g, float up) const { return g * __builtin_amdgcn_rcpf(1.f + __builtin_amdgcn_exp2f(-1.4426950408889634f * g)) * up; }
    __device__ __forceinline__ void store8(const GUnit& u, int r, int c, f32x4 v0, f32x4 v1) const {
        u32x2 w; w.x = cvtpk(su(v0[0], v0[1]), su(v0[2], v0[3])); w.y = cvtpk(su(v1[0], v1[1]), su(v1[2], v1[3]));
        *(GAS u32x2*)(act + (size_t)(u.orow0 + r) * DE + ((u.ocol0 + c) >> 1)) = w;
    }
};

template <class Epi, class Sched>
__device__ __forceinline__ void gemm_simple(const GemmA g, const Sched& S, const Epi& E, const int tid) {
    const int wid = tid >> 6, lane = tid & 63, fr = lane & 15, fq = lane >> 4;
    GUnit u;
    for (int i = 0; S.next(i, u); ++i) {
        size_t aoff[2];
#pragma unroll
        for (int mi = 0; mi < 2; ++mi) { const int tr = 32 * wid + 16 * mi + fr; const int grow = u.amap ? (tr < u.avalid ? u.amap[tr] : 0) : u.arow0 + tr; aoff[mi] = (size_t)grow * g.lda + 8 * fq; }
        for (int cb = 0; cb < 8; ++cb) {
            f32x4 acc[2][2];
#pragma unroll
            for (int a = 0; a < 2; ++a)
#pragma unroll
                for (int b = 0; b < 2; ++b) acc[a][b] = (f32x4){0.f, 0.f, 0.f, 0.f};
            size_t boff[2];
#pragma unroll
            for (int n = 0; n < 2; ++n) { const int col = Epi::PERM ? 32 * cb + 8 * (fr >> 2) + 4 * n + (fr & 3) : 32 * cb + 16 * n + fr; boff[n] = (size_t)col * g.K + 8 * fq; }
            for (int k0 = 0; k0 < g.K; k0 += 32) {
                bf16x8 a[2], b[2];
#pragma unroll
                for (int mi = 0; mi < 2; ++mi) a[mi] = *(const GAS bf16x8*)(g.A + aoff[mi] + k0);
#pragma unroll
                for (int n = 0; n < 2; ++n) b[n] = *(const GAS bf16x8*)(u.Bt + boff[n] + k0);
#pragma unroll
                for (int mi = 0; mi < 2; ++mi)
#pragma unroll
                    for (int n = 0; n < 2; ++n) acc[mi][n] = __builtin_amdgcn_mfma_f32_16x16x32_bf16(b[n], a[mi], acc[mi][n], 0, 0, 0);
            }
#pragma unroll
            for (int mi = 0; mi < 2; ++mi) { const int r = 32 * wid + 16 * mi + fr;
                if constexpr (Epi::PERM) E.store8(u, r, 32 * cb + 8 * fq, acc[mi][0], acc[mi][1]);
                else {
#pragma unroll
                    for (int n = 0; n < 2; ++n) E.store4(u, r, 32 * cb + 16 * n + 4 * fq, acc[mi][n]); } }
        }
    }
}

namespace pg8 {
constexpr int BM = 256, BK = 64, HALF = 128, HTB = HALF * BK * 2, STAGE_BYTES = 8 * HTB;
__device__ __forceinline__ int lds_byte(int r, int c) { const int st = (r >> 4) * 2 + (c >> 5), rr = r & 15, cc = c & 31, ob = rr * 64 + cc * 2; return st * 1024 + (ob ^ (((ob >> 9) & 1) << 5)); }
__device__ __forceinline__ void stage_rc(int b, int& R, int& C) { const int st = b / 1024, sb = b % 1024, swz = sb ^ (((sb >> 9) & 1) << 5); R = (st >> 1) * 16 + swz / 64; C = (st & 1) * 32 + (swz % 64) / 2; }
__device__ __forceinline__ int perm32(int rho) { const int n = rho >> 4, i = rho & 15; return 8 * (i >> 2) + 4 * n + (i & 3); }

template <class Epi>
__device__ __forceinline__ void run_epi(const Epi& E, const f32x4 (&acc)[2][2][4][2], const GUnit& u, int wr, int wc, int fr, int fq, const LAS float* tab) {
#pragma unroll
    for (int ai = 0; ai < 2; ++ai)
#pragma unroll
        for (int m = 0; m < 4; ++m) { const int r = ai * HALF + wr * 64 + m * 16 + fr;
            float pre; if constexpr (Epi::TABPRE) pre = tab[r]; else pre = E.rowpre(u, r);
            float ss = 0.f;
#pragma unroll
            for (int bj = 0; bj < 2; ++bj) {
                if constexpr (Epi::PERM) { const f32x4 v0 = acc[ai][bj][m][0] * pre, v1 = acc[ai][bj][m][1] * pre;
                    E.store8(u, r, bj * HALF + wc * 32 + 8 * fq, v0, v1);
                    if constexpr (Epi::ROWSS) ss += ((v0[0] * v0[0] + v0[1] * v0[1]) + (v0[2] * v0[2] + v0[3] * v0[3])) + ((v1[0] * v1[0] + v1[1] * v1[1]) + (v1[2] * v1[2] + v1[3] * v1[3])); }
                else {
#pragma unroll
                    for (int n = 0; n < 2; ++n) E.store4(u, r, bj * HALF + wc * 32 + 16 * n + 4 * fq, acc[ai][bj][m][n]); } }
            if constexpr (Epi::ROWSS) { ss = half_sum(quarter_sum(ss)); if (fq == 0) E.rowss(u, r, wc, ss); } }
}
template <class Epi>
__device__ __forceinline__ void run_epi_resid(const Epi& E, const f32x4 (&acc)[2][2][4][2], const GUnit& u, int wr, int wc, int fr, int fq, const LAS float* tab) {
    f32x4 gt[2][2]; float rsb8[2][4];
#pragma unroll
    for (int a = 0; a < 2; ++a)
#pragma unroll
        for (int m = 0; m < 4; ++m) rsb8[a][m] = tab[256 + a * HALF + wr * 64 + m * 16 + fr];
#pragma unroll
    for (int bj = 0; bj < 2; ++bj)
#pragma unroll
        for (int n = 0; n < 2; ++n) gt[bj][n] = E.gate4(u, bj * HALF + wc * 32 + 8 * fq + 4 * n);
#pragma unroll
    for (int ai = 0; ai < 2; ++ai) {
        u32x4 xi[4][2];
#pragma unroll
        for (int m = 0; m < 4; ++m)
#pragma unroll
            for (int bj = 0; bj < 2; ++bj) xi[m][bj] = E.load8(u, ai * HALF + wr * 64 + m * 16 + fr, bj * HALF + wc * 32 + 8 * fq);
#pragma unroll
        for (int m = 0; m < 4; ++m)
#pragma unroll
            for (int bj = 0; bj < 2; ++bj) { const u32x4 w = xi[m][bj]; const float rs = rsb8[ai][m];
                const f32x4 a0 = acc[ai][bj][m][0] * rs, a1 = acc[ai][bj][m][1] * rs, g0 = gt[bj][0], g1 = gt[bj][1];
                u32x4 o;
                o.x = cvtpk(bflo(w.x) + g0[0] * a0[0], bfhi(w.x) + g0[1] * a0[1]); o.y = cvtpk(bflo(w.y) + g0[2] * a0[2], bfhi(w.y) + g0[3] * a0[3]);
                o.z = cvtpk(bflo(w.z) + g1[0] * a1[0], bfhi(w.z) + g1[1] * a1[1]); o.w = cvtpk(bflo(w.w) + g1[2] * a1[2], bfhi(w.w) + g1[3] * a1[3]);
                E.put8(u, ai * HALF + wr * 64 + m * 16 + fr, bj * HALF + wc * 32 + 8 * fq, o); }
        asm volatile("" ::: "memory");
    }
}

template <class Epi>
__device__ __forceinline__ void run_epi_kv(const Epi& E, const f32x4 (&acc)[2][2][4][2], const GUnit& u, int wr, int wc, int fr, int fq, const LAS float* tab, LAS unsigned char* lds, int tid) {
    { const int ln_ = lane_id_volatile(); fr = ln_ & 15; fq = ln_ >> 4; tid = (wr * 4 + wc) * 64 + ln_; }
    LAS float* part = (LAS float*)(lds + LDS_X + 256 + 4096); LAS float* krs = part + 1024;
    const int h = u.ocol0 >> 8;
#pragma unroll
    for (int ai = 0; ai < 2; ++ai)
#pragma unroll
        for (int m = 0; m < 4; ++m) { const int r = ai * HALF + wr * 64 + m * 16 + fr; const float pre = tab[r];
            { const f32x4 v0 = acc[ai][1][m][0] * pre, v1 = acc[ai][1][m][1] * pre;
              u32x4 w; w.x = cvtpk(v0[0], v0[1]); w.y = cvtpk(v0[2], v0[3]); w.z = cvtpk(v1[0], v1[1]); w.w = cvtpk(v1[2], v1[3]);
              *(GAS u32x4*)((bf16_t*)(E.ws + WS_KVRAW) + (size_t)(u.orow0 + r) * 2048 + u.ocol0 + HALF + wc * 32 + 8 * fq) = w; }
            { const f32x4 v0 = acc[ai][0][m][0] * pre, v1 = acc[ai][0][m][1] * pre;
              float ss = ((v0[0] * v0[0] + v0[1] * v0[1]) + (v0[2] * v0[2] + v0[3] * v0[3])) + ((v1[0] * v1[0] + v1[1] * v1[1]) + (v1[2] * v1[2] + v1[3] * v1[3]));
              ss = half_sum(quarter_sum(ss)); if (fq == 0) part[wc * 256 + r] = ss; } }
    const int hf = __builtin_amdgcn_readfirstlane(tid >> 8), row = tid & 255, j0 = hf * 16, t = u.orow0 + row, pos = t & (SEQ - 1);
    float o1[16], o2[16];
    { const bf16_t* kr = (const bf16_t*)(E.ws + WS_PROJ) + (size_t)t * INP + C_KR + j0;
      const u32x4 a0 = *(const GAS u32x4*)kr, a1 = *(const GAS u32x4*)(kr + 8), b0 = *(const GAS u32x4*)(kr + 32), b1 = *(const GAS u32x4*)(kr + 40);
      const float* cp = (const float*)(E.ws + WS_ROPE) + (size_t)pos * 32 + j0; const float* sp = cp + SEQ * 32; const float* g1 = E.kg + 128 + j0; const float* g2 = g1 + 32;
      const unsigned aw[8] = {a0.x, a0.y, a0.z, a0.w, a1.x, a1.y, a1.z, a1.w}, bw[8] = {b0.x, b0.y, b0.z, b0.w, b1.x, b1.y, b1.z, b1.w};
      float sq = 0.f;
#pragma unroll
      for (int q = 0; q < 4; ++q) { const f32x4 c = *(const GAS f32x4*)(cp + 4 * q), sn = *(const GAS f32x4*)(sp + 4 * q), ga = *(const GAS f32x4*)(g1 + 4 * q), gb = *(const GAS f32x4*)(g2 + 4 * q);
#pragma unroll
          for (int i = 0; i < 4; ++i) { const int j = 4 * q + i; const float ka = (j & 1) ? bfhi(aw[j >> 1]) : bflo(aw[j >> 1]), kb = (j & 1) ? bfhi(bw[j >> 1]) : bflo(bw[j >> 1]);
              sq += ka * ka + kb * kb; const float x1 = ka * ga[i], x2 = kb * gb[i];
              o1[j] = x1 * c[i] - x2 * sn[i]; o2[j] = x1 * sn[i] + x2 * c[i]; } }
      krs[hf * 256 + row] = sq; }
    asm volatile("s_waitcnt lgkmcnt(0)" ::: "memory");
    __builtin_amdgcn_s_barrier();
    { const f32x4 gn0 = *(const GAS f32x4*)(E.kg + wc * 32 + 8 * fq), gn1 = *(const GAS f32x4*)(E.kg + wc * 32 + 8 * fq + 4);
#pragma unroll
      for (int ai = 0; ai < 2; ++ai)
#pragma unroll
        for (int m = 0; m < 4; ++m) { const int r = ai * HALF + wr * 64 + m * 16 + fr;
            const float rk = rsqrtf((((part[r] + part[256 + r]) + (part[512 + r] + part[768 + r])) + (krs[r] + krs[256 + r])) * (1.f / QK) + EPS), sc = tab[r] * rk;
            const f32x4 v0 = acc[ai][0][m][0] * sc * gn0, v1 = acc[ai][0][m][1] * sc * gn1;
            u32x4 w; w.x = cvtpk(v0[0], v0[1]); w.y = cvtpk(v0[2], v0[3]); w.z = cvtpk(v1[0], v1[1]); w.w = cvtpk(v1[2], v1[3]);
            *(GAS u32x4*)((bf16_t*)(E.ws + WS_KF) + (size_t)(u.orow0 + r) * 1536 + h * QK + wc * 32 + 8 * fq) = w; } }
    { const float rk = rsqrtf((((part[row] + part[256 + row]) + (part[512 + row] + part[768 + row])) + (krs[row] + krs[256 + row])) * (1.f / QK) + EPS);
      bf16_t* dst = (bf16_t*)(E.ws + WS_KF) + (size_t)t * 1536 + h * QK + 128 + j0;
      u32x4 w;
      w.x = cvtpk(o1[0] * rk, o1[1] * rk); w.y = cvtpk(o1[2] * rk, o1[3] * rk); w.z = cvtpk(o1[4] * rk, o1[5] * rk); w.w = cvtpk(o1[6] * rk, o1[7] * rk); *(GAS u32x4*)dst = w;
      w.x = cvtpk(o1[8] * rk, o1[9] * rk); w.y = cvtpk(o1[10] * rk, o1[11] * rk); w.z = cvtpk(o1[12] * rk, o1[13] * rk); w.w = cvtpk(o1[14] * rk, o1[15] * rk); *(GAS u32x4*)(dst + 8) = w;
      w.x = cvtpk(o2[0] * rk, o2[1] * rk); w.y = cvtpk(o2[2] * rk, o2[3] * rk); w.z = cvtpk(o2[4] * rk, o2[5] * rk); w.w = cvtpk(o2[6] * rk, o2[7] * rk); *(GAS u32x4*)(dst + 32) = w;
      w.x = cvtpk(o2[8] * rk, o2[9] * rk); w.y = cvtpk(o2[10] * rk, o2[11] * rk); w.z = cvtpk(o2[12] * rk, o2[13] * rk); w.w = cvtpk(o2[14] * rk, o2[15] * rk); *(GAS u32x4*)(dst + 40) = w; }
    asm volatile("s_waitcnt lgkmcnt(0)" ::: "memory");
}

template <class Epi, class Sched>
__device__ __forceinline__ void gemm_phase(LAS unsigned char* lds, const GemmA g, const Sched& S, const Epi& E, const int tid) {
    const int wid = __builtin_amdgcn_readfirstlane(tid >> 6), lane = tid & 63, wr = wid >> 2, wc = wid & 3, fr = lane & 15, fq = lane >> 4;
    const int K = g.K, nt = K / BK, lda = g.lda;
    unsigned voffB[2];
#pragma unroll
    for (int i = 0; i < 2; ++i) { int R, C; stage_rc(tid * 16 + i * 8192, R, C); const int Rb = Epi::PERM ? ((R & ~31) + perm32(R & 31)) : R; voffB[i] = (unsigned)(Rb * K + C) * 2u; }
    unsigned voffA[2][2];
#define PG8_SETA(u_) do { const int _t16 = (wid * 64 + lane_id_volatile()) * 16;                   \
        _Pragma("unroll") for (int _h = 0; _h < (Sched::GATHER ? 2 : 1); ++_h) _Pragma("unroll") for (int _i = 0; _i < 2; ++_i) { int _R, _C; stage_rc(_t16 + _i * 8192, _R, _C); const int _tr = _h * HALF + _R; \
        const int _gr = (u_).amap ? (_tr < (u_).avalid ? (u_).amap[_tr] : 0) : (u_).arow0 + _tr; voffA[_h][_i] = (unsigned)(_gr * lda + _C) * 2u; } } while (0)
    const size_t kstep = (size_t)(BK * 2);
    const size_t hstepB = (size_t)HALF * K * 2, hstepA = (size_t)HALF * lda * 2;
    const unsigned ldsw = (unsigned)wid * 1024u;
    const int aoff = lds_byte(wr * 64 + fr, fq * 8), boff = lds_byte(wc * 32 + fr, fq * 8);
#define PG8_SA(b, h) (((b) * 2 + (h)) * HTB)
#define PG8_SB(b, h) ((4 + (b) * 2 + (h)) * HTB)
#define PG8_STAGE(bufoff, gbase, voff) do { _Pragma("unroll") for (int _i = 0; _i < 2; ++_i) \
        __builtin_amdgcn_global_load_lds((const unsigned*)((const char*)(gbase) + (voff)[_i]), (LAS unsigned*)(lds + (bufoff) + ldsw + _i * 8192), 16, 0, 0); } while (0)
#define PG8_STAGE_A1(bufoff, gbase) do { if constexpr (Sched::GATHER) PG8_STAGE(bufoff, gbase, voffA[1]); else PG8_STAGE(bufoff, (gbase) + hstepA, voffA[0]); } while (0)
#define PG8_LDA(dst, b, h) do { _Pragma("unroll") for (int m = 0; m < 4; ++m) _Pragma("unroll") for (int k = 0; k < 2; ++k) dst[m][k] = *(const LAS bf16x8*)(lds + PG8_SA(b, h) + aoff + m * 2048 + k * 1024); } while (0)
#define PG8_LDB(dst, b, h) do { _Pragma("unroll") for (int n = 0; n < 2; ++n) _Pragma("unroll") for (int k = 0; k < 2; ++k) dst[n][k] = *(const LAS bf16x8*)(lds + PG8_SB(b, h) + boff + n * 2048 + k * 1024); } while (0)
#define PG8_MMA(ai, bj, At, Bt) do { __builtin_amdgcn_s_setprio(1); _Pragma("unroll") for (int m = 0; m < 4; ++m) _Pragma("unroll") for (int n = 0; n < 2; ++n) _Pragma("unroll") for (int k = 0; k < 2; ++k) \
        acc[ai][bj][m][n] = __builtin_amdgcn_mfma_f32_16x16x32_bf16(Bt[n][k], At[m][k], acc[ai][bj][m][n], 0, 0, 0); __builtin_amdgcn_s_setprio(0); } while (0)
#define PG8_WAIT_V(n) asm volatile("s_waitcnt vmcnt(" #n ")" ::: "memory")
#define PG8_WAIT_L(n) asm volatile("s_waitcnt lgkmcnt(" #n ")" ::: "memory")
#define PG8_BAR __builtin_amdgcn_s_barrier()
#define PG8_SCHED __builtin_amdgcn_sched_barrier(0)
    GUnit cur, nxt; int ui = 0;
    if (!S.next(0, cur)) return;
    f32x4 acc[2][2][4][2];
#pragma unroll
    for (int a = 0; a < 2; ++a)
#pragma unroll
        for (int b = 0; b < 2; ++b)
#pragma unroll
            for (int m = 0; m < 4; ++m)
#pragma unroll
                for (int n = 0; n < 2; ++n) acc[a][b][m][n] = (f32x4){0.f, 0.f, 0.f, 0.f};
    bf16x8 At[4][2], B0[2][2], B1[2][2];
    LAS float* rtab = (LAS float*)(lds + LDS_X + 256);
    if constexpr (Epi::RESC || Epi::TABPRE) E.rs_table(cur, tid, rtab);
    const char* cA = (const char*)g.A; const char* cB = (const char*)cur.Bt;
    PG8_SETA(cur);
    asm volatile("s_waitcnt vmcnt(0)" ::: "memory");
    PG8_STAGE(PG8_SB(0, 0), cB, voffB); PG8_STAGE(PG8_SB(0, 1), cB + hstepB, voffB); PG8_STAGE(PG8_SA(0, 0), cA, voffA[0]); PG8_STAGE_A1(PG8_SA(0, 1), cA);
    if (wr == 1) PG8_BAR;
    PG8_WAIT_V(2); PG8_BAR;
    PG8_STAGE(PG8_SB(1, 0), cB + kstep, voffB); PG8_STAGE(PG8_SA(1, 0), cA + kstep, voffA[0]); PG8_STAGE(PG8_SB(1, 1), cB + hstepB + kstep, voffB);
    PG8_WAIT_V(6); PG8_BAR;
    for (;;) {
        const bool has_next = S.next(ui + 1, nxt);
        const char* nB = has_next ? (const char*)nxt.Bt : cB;

        for (int t = 0; t < nt; t += 2) {
            const bool last = (t == nt - 2);
            const char* a1 = cA + (size_t)(t + 1) * kstep;
            const char* a2 = last ? cA : cA + (size_t)(t + 2) * kstep; const char* b2 = last ? nB : cB + (size_t)(t + 2) * kstep;
            const char* a3 = a2 + kstep; const char* b3 = b2 + kstep;
            if constexpr (Epi::RESC) {
                if (t == nt / 2) {
#pragma unroll
                    for (int ai = 0; ai < 2; ++ai)
#pragma unroll
                        for (int m = 0; m < 4; ++m) { const float ratio = rtab[(ui & 1) * 512 + ai * HALF + wr * 64 + m * 16 + fr];
#pragma unroll
                            for (int bj = 0; bj < 2; ++bj)
#pragma unroll
                                for (int n = 0; n < 2; ++n) acc[ai][bj][m][n] *= ratio; } } }
            PG8_LDB(B0, 0, 0); PG8_LDB(B1, 0, 1); PG8_SCHED; PG8_LDA(At, 0, 0); PG8_STAGE_A1(PG8_SA(1, 1), a1);
            if (last && has_next) { PG8_SETA(nxt); if constexpr (Epi::RESC || Epi::TABPRE) E.rs_table(nxt, wid * 64 + lane_id_volatile(), rtab + ((ui + 1) & 1) * 512); }
            PG8_WAIT_V(8); PG8_WAIT_L(0); PG8_BAR; PG8_MMA(0, 0, At, B0); PG8_MMA(0, 1, At, B1); PG8_BAR; PG8_SCHED;
            PG8_LDA(At, 0, 1); PG8_STAGE(PG8_SB(0, 0), b2, voffB); PG8_STAGE(PG8_SB(0, 1), b2 + hstepB, voffB); PG8_STAGE(PG8_SA(0, 0), a2, voffA[0]);
            PG8_WAIT_V(8); PG8_WAIT_L(0); PG8_BAR; PG8_MMA(1, 0, At, B0); PG8_MMA(1, 1, At, B1); PG8_BAR; PG8_SCHED;
            PG8_LDB(B0, 1, 0); PG8_LDB(B1, 1, 1); PG8_SCHED; PG8_LDA(At, 1, 0); PG8_STAGE_A1(PG8_SA(0, 1), a2);
            PG8_WAIT_V(8); PG8_WAIT_L(0); PG8_BAR; PG8_MMA(0, 0, At, B0); PG8_MMA(0, 1, At, B1); PG8_BAR; PG8_SCHED;
            PG8_LDA(At, 1, 1); PG8_STAGE(PG8_SB(1, 0), b3, voffB); PG8_STAGE(PG8_SB(1, 1), b3 + hstepB, voffB); PG8_STAGE(PG8_SA(1, 0), a3, voffA[0]);
            PG8_WAIT_V(8); PG8_WAIT_L(0); PG8_BAR; PG8_MMA(1, 0, At, B0); PG8_MMA(1, 1, At, B1); PG8_BAR; PG8_SCHED;
        }
        if (wr == 0) PG8_BAR;
        if constexpr (Epi::KVK) run_epi_kv(E, acc, cur, wr, wc, fr, fq, rtab + (ui & 1) * 512, lds, 0); else if constexpr (!Epi::RESID) run_epi(E, acc, cur, wr, wc, fr, fq, rtab + (ui & 1) * 512); else run_epi_resid(E, acc, cur, wr, wc, fr, fq, rtab + (ui & 1) * 512);
        if (!has_next) break;
#pragma unroll
        for (int a = 0; a < 2; ++a)
#pragma unroll
            for (int b = 0; b < 2; ++b)
#pragma unroll
                for (int m = 0; m < 4; ++m)
#pragma unroll
                    for (int n = 0; n < 2; ++n) acc[a][b][m][n] = (f32x4){0.f, 0.f, 0.f, 0.f};
        cur = nxt; cB = nB; ++ui;
        if (wr == 1) PG8_BAR;
    }
    PG8_WAIT_V(0);
    PG8_BAR;
#undef PG8_SETA
#undef PG8_SA
#undef PG8_SB
#undef PG8_STAGE
#undef PG8_STAGE_A1
#undef PG8_LDA
#undef PG8_LDB
#undef PG8_MMA
#undef PG8_WAIT_V
#undef PG8_WAIT_L
#undef PG8_BAR
#undef PG8_SCHED
}
}

template <class Epi, class Sched>
__device__ __forceinline__ void gemm_run(Ctx& X, const GemmA g, const Sched& S, const Epi& E) {
#if MK_SIMPLE_GEMM
    gemm_simple(g, S, E, X.tid);
#else
    pg8::gemm_phase(X.lds, g, S, E, X.tid);
#endif
}

__device__ __forceinline__ void conv_tile(const float* W, int ldw, int K, bf16_t* WT, int k0, int n0, int dmul, int dadd, float sc, LAS bf16_t* scr, int lane, const float* ksc = nullptr) {
    constexpr int PITCH = 72;
    f32x4 v[16];
    const int nq = (lane & 15) * 4, kq = lane >> 4;
#pragma unroll
    for (int i = 0; i < 16; ++i) v[i] = __builtin_nontemporal_load((const GAS f32x4*)(W + (size_t)(k0 + 4 * i + kq) * ldw + n0 + nq));
#pragma unroll
    for (int i = 0; i < 16; ++i) { const int k = 4 * i + kq; const float sk = ksc ? sc * ksc[k0 + k] : sc;
#pragma unroll
        for (int j = 0; j < 4; ++j) scr[(nq + j) * PITCH + k] = f2bf(v[i][j] * sk); }
    asm volatile("s_waitcnt lgkmcnt(0)" ::: "memory");
    const int c = lane & 7;
#pragma unroll
    for (int j = 0; j < 8; ++j) { const int n = (lane >> 3) + 8 * j;
        const u32x4 o = *(const LAS u32x4*)(scr + n * PITCH + 8 * c);
        __builtin_nontemporal_store(o, (GAS u32x4*)(WT + (size_t)((n0 + n) * dmul + dadd) * K + k0 + 8 * c)); }
    asm volatile("s_waitcnt lgkmcnt(0)" ::: "memory");
}

constexpr int CV_PER_L = 1952 + 192 + 128 + 1024, CV_PER_LE = 768, CV_NL = CV_PER_L + 16 * CV_PER_LE;
__device__ __forceinline__ void conv_item(const Params& p, unsigned char* ws, int L, int r, LAS bf16_t* scr, int lane) {
    const float* W; bf16_t* WT; const float* ksc = nullptr; int ldw, K, k0, n0, dmul = 1, dadd = 0; float sc = 1.f;
    if (r < CV_PER_L) {
        if (r < 1952) { const int kt = r / 61, nt = r % 61; n0 = nt * 64; k0 = kt * 64; sc = (n0 >= C_SQ && n0 < C_SK) ? QSCALE_SB : 1.f;
            W = p.w_in + (size_t)L * D * INC; ldw = INC; K = D; WT = (bf16_t*)(ws + WS_WIN) + (size_t)L * INP * D; }
        else if (r < 1952 + 192) { const int q = r - 1952, kt = q / 24, nt = q % 24; k0 = kt * 64; n0 = nt * 64;
            W = p.w_uq + (size_t)L * QL * 1536; ldw = 1536; K = QL; WT = (bf16_t*)(ws + WS_WUQ) + (size_t)L * 1536 * QL; ksc = p.q_lora_g + L * QL; }
        else if (r < 1952 + 192 + 128) { const int q = r - 1952 - 192, kt = q / 32, nt = q % 32; k0 = kt * 64; n0 = nt * 64;
            W = p.w_ukv + (size_t)L * KVL * 2048; ldw = 2048; K = KVL; WT = (bf16_t*)(ws + WS_WUKV) + (size_t)L * 2048 * KVL; ksc = p.kv_lora_g + L * KVL; }
        else { const int q = r - 1952 - 192 - 128, kt = q / 32, nt = q % 32; k0 = kt * 64; n0 = nt * 64;
            W = p.w_o + (size_t)L * D * D; ldw = D; K = D; WT = (bf16_t*)(ws + WS_WO) + (size_t)L * D * D; ksc = kt < 16 ? p.mla_out_g + L * 1024 : p.sb_out_g + L * 1024 - 1024; }
    } else { const int q0 = r - CV_PER_L, le = L * 16 + q0 / CV_PER_LE, q = q0 % CV_PER_LE;
        if (q < 512) { const int qq = q & 255, kt = qq / 8, nt = qq % 8; k0 = kt * 64; n0 = nt * 64; dmul = 2; dadd = q >> 8;
            W = (q < 256 ? p.w_gate : p.w_up) + (size_t)le * D * DE; ldw = DE; K = D; WT = (bf16_t*)(ws + WS_WGU) + (size_t)le * 1024 * D; }
        else { const int qq = q - 512, kt = qq / 32, nt = qq % 32; k0 = kt * 64; n0 = nt * 64;
            W = p.w_down + (size_t)le * DE * D; ldw = D; K = DE; WT = (bf16_t*)(ws + WS_WDN) + (size_t)le * D * DE; }
    }
    conv_tile(W, ldw, K, WT, k0, n0, dmul, dadd, sc, scr, lane, ksc);
}

__device__ __forceinline__ void phase_prologue(const Params& p, Ctx& X) {
    unsigned char* ws = p.ws;
    LAS float* cact = (LAS float*)X.lds;
    for (int i = X.tid; i < NB * D; i += NTHR) { const float c = p.c[i]; cact[i] = c / (1.f + expf(-c)); }
    __syncthreads();
    { float* ct = (float*)(ws + WS_ROPE); float* st = ct + SEQ * 32;
      for (int i = X.blk * NTHR + X.tid; i < SEQ * 32; i += X.G * NTHR) { const int pos = i >> 5, j = i & 31;
          const float ang = (float)pos * ROPE_INV[j]; const double rev = (double)ang * 0.15915494309189535; const float fr = (float)(rev - floor(rev));
          ct[i] = __builtin_amdgcn_cosf(fr); st[i] = __builtin_amdgcn_sinf(fr); } }
    { float* rwt = (float*)(ws + WS_RWT);
      for (int i = X.blk * NTHR + X.tid; i < D * NE; i += X.G * NTHR) rwt[(size_t)(i & 15) * D + (i >> 4)] = p.router_w[i]; }
    const bool fastmod = X.ngw >= 4 * 48 * 8 && NWAVES == 8; LAS float* mpart = (LAS float*)(X.lds + 16384);
    { float* modp = (float*)(ws + WS_MODP);
      for (int it = X.gw; it < 4 * 48 * 8; it += X.ngw) { const int kc = it & 7, cg = (it >> 3) % 48, l = it / (8 * 48);
          const float* w = p.w_ada + ((size_t)l * D + kc * 256) * 12288 + cg * 256 + 4 * X.lane;
          f32x4 a0 = {0.f, 0.f, 0.f, 0.f}, a1 = {0.f, 0.f, 0.f, 0.f};
#pragma unroll 8
          for (int k = 0; k < 256; ++k) { const f32x4 wv = __builtin_nontemporal_load((const GAS f32x4*)(w + (size_t)k * 12288)); const float s0 = cact[kc * 256 + k], s1 = cact[D + kc * 256 + k]; a0 += s0 * wv; a1 += s1 * wv; }
          if (fastmod) { *(LAS f32x4*)(mpart + X.wave * 512 + 4 * X.lane) = a0; *(LAS f32x4*)(mpart + X.wave * 512 + 256 + 4 * X.lane) = a1; }
          else { float* o = modp + (((size_t)kc * 4 + l) * 2) * 12288 + cg * 256 + 4 * X.lane;
                 *(GAS f32x4*)o = a0; *(GAS f32x4*)(o + 12288) = a1; } } }
    __syncthreads();
    if (fastmod && X.blk * NWAVES < 4 * 48 * 8) { const int b = X.tid >> 8, c = X.tid & 255, l = X.blk / 48, cg = X.blk % 48, j = cg * 256 + c;
        float sm = p.b_ada[l * 12288 + j];
#pragma unroll
        for (int kc = 0; kc < 8; ++kc) sm += mpart[kc * 512 + b * 256 + c];
        const int i = (l * 2 + b) * 12288 + j;
        ((float*)(ws + WS_MOD))[i] = sm;
        if (j >= 4 * D && j < 5 * D) ((float*)(ws + WS_MOD2))[i / 12288 * D + (j - 4 * D)] = p.norm2_g[l * D + (j - 4 * D)] * (1.f + sm);
        if (j >= D && j < 2 * D) ((float*)(ws + WS_MOD2 + 65536))[i / 12288 * D + (j - D)] = p.norm1_g[l * D + (j - D)] * (1.f + sm); }
    __syncthreads();
    LAS bf16_t* scr = (LAS bf16_t*)(X.lds + 16384 + X.wave * 10240);
    for (int r = X.gw; r < CV_NL; r += X.ngw) conv_item(p, ws, 0, r, scr, X.lane);
    { const u32x4 z = {0u, 0u, 0u, 0u};
      for (int i = X.blk * NTHR + X.tid; i < 4 * 192 * (D / 8); i += X.G * NTHR) { const int l = i / (192 * (D / 8)), r = i % (192 * (D / 8));
          *(GAS u32x4*)((bf16_t*)(ws + WS_WIN) + ((size_t)l * INP + INC) * D + (size_t)r * 8) = z; } }
}

__device__ __forceinline__ void phase_modreduce(const Params& p, Ctx& X) {
    const float* modp = (const float*)(p.ws + WS_MODP); float* mod = (float*)(p.ws + WS_MOD);
    for (int i = X.blk * NTHR + X.tid; i < 4 * 2 * 12288; i += X.G * NTHR) { const int j = i % 12288, l = i / (2 * 12288);
        float s = p.b_ada[l * 12288 + j];
#pragma unroll
        for (int kc = 0; kc < 8; ++kc) s += modp[(size_t)kc * (4 * 2 * 12288) + i];
        mod[i] = s;
        if (j >= 4 * D && j < 5 * D) ((float*)(p.ws + WS_MOD2))[i / 12288 * D + (j - 4 * D)] = p.norm2_g[l * D + (j - 4 * D)] * (1.f + s);
        if (j >= D && j < 2 * D) ((float*)(p.ws + WS_MOD2 + 65536))[i / 12288 * D + (j - D)] = p.norm1_g[l * D + (j - D)] * (1.f + s); }
}

__device__ __forceinline__ void load_counts(const Params& p, Ctx& X, int l, LAS int* cnt, LAS int* rb) {
    if (X.tid < NE) { const unsigned* c = (const unsigned*)(p.ws + WS_CTL) + CW_CNT + (l * 16 + X.tid) * 64;
        const int ce = (int)__hip_atomic_load(c, __ATOMIC_RELAXED, __HIP_MEMORY_SCOPE_AGENT);
        LAS int* tmp = rb + 16; cnt[X.tid] = ce; tmp[X.tid] = ((ce + 255) >> 8) << 8;
        asm volatile("s_waitcnt lgkmcnt(0)" ::: "memory");
        int acc = 0;
#pragma unroll
        for (int k = 0; k < NE; ++k) { const int v = tmp[k]; if (k < X.tid) acc += v; }
        rb[X.tid] = acc; }
    __syncthreads();
}
__device__ __forceinline__ void load_row_combine(const Params& p, Ctx& X, int t, int l, const LAS int* rb, f32x4 (&v)[8]) {
    const int b = t >> 12;
    const float* xr = (l == 0 ? p.x : p.out) + (size_t)t * D + 4 * X.lane;
#pragma unroll
    for (int j = 0; j < 8; ++j) v[j] = *(const GAS f32x4*)(xr + 256 * j);
#if !defined(MK_SKIP_MOE) && !defined(MK_NO_COMBINE)
    if (l > 0) {
        const int* sl = (const int*)(p.ws + WS_SLOT) + (size_t)t * 8;
        const int e0 = sl[0], p0 = sl[1], e1 = sl[2], p1 = sl[3]; const float w0 = __int_as_float(sl[4]), w1 = __int_as_float(sl[5]);
        const bf16_t* y0 = (const bf16_t*)(p.ws + WS_Y) + (size_t)(rb[e0] + p0) * D + 4 * X.lane;
        const bf16_t* y1 = (const bf16_t*)(p.ws + WS_Y) + (size_t)(rb[e1] + p1) * D + 4 * X.lane;
        const float* gf = (const float*)(p.ws + WS_MOD) + ((size_t)(l - 1) * 2 + b) * 12288 + 5 * D + 4 * X.lane;
#pragma unroll
        for (int j = 0; j < 8; ++j) { const u32x2 a = *(const GAS u32x2*)(y0 + 256 * j), c = *(const GAS u32x2*)(y1 + 256 * j); const f32x4 g = *(const GAS f32x4*)(gf + 256 * j);
            v[j][0] += g[0] * (w0 * bflo(a.x) + w1 * bflo(c.x)); v[j][1] += g[1] * (w0 * bfhi(a.x) + w1 * bfhi(c.x));
            v[j][2] += g[2] * (w0 * bflo(a.y) + w1 * bflo(c.y)); v[j][3] += g[3] * (w0 * bfhi(a.y) + w1 * bfhi(c.y)); }
    }
#endif
}
__device__ __forceinline__ void norm_mod(Ctx& X, f32x4 (&v)[8], const float* g, const float* shift, const float* scale) {
    float ss = 0.f;
#pragma unroll
    for (int j = 0; j < 8; ++j) ss += (v[j][0] * v[j][0] + v[j][1] * v[j][1]) + (v[j][2] * v[j][2] + v[j][3] * v[j][3]);
    const float rstd = rsqrtf(wave_sum(ss) * (1.f / D) + EPS);
#pragma unroll
    for (int j = 0; j < 8; ++j) { const f32x4 gg = *(const GAS f32x4*)(g + 4 * X.lane + 256 * j), sh = *(const GAS f32x4*)(shift + 4 * X.lane + 256 * j), sc = *(const GAS f32x4*)(scale + 4 * X.lane + 256 * j);
        v[j] = v[j] * rstd * gg * (1.f + sc) + sh; }
}
__device__ __forceinline__ void norm_mod2(Ctx& X, f32x4 (&v)[8], const float* a, const float* shift) {
    f32x4 aa[8], sh[8];
#pragma unroll
    for (int j = 0; j < 8; ++j) { aa[j] = *(const GAS f32x4*)(a + 4 * X.lane + 256 * j); sh[j] = *(const GAS f32x4*)(shift + 4 * X.lane + 256 * j); }
    asm volatile("" ::: "memory");
    float ss = 0.f;
#pragma unroll
    for (int j = 0; j < 8; ++j) ss += (v[j][0] * v[j][0] + v[j][1] * v[j][1]) + (v[j][2] * v[j][2] + v[j][3] * v[j][3]);
    const float rstd = rsqrtf(wave_sum(ss) * (1.f / D) + EPS);
#pragma unroll
    for (int j = 0; j < 8; ++j) v[j] = v[j] * rstd * aa[j] + sh[j];
}
__device__ __forceinline__ void store_row_bf16(Ctx& X, bf16_t* dst, const f32x4 (&v)[8]) {
#pragma unroll
    for (int j = 0; j < 8; ++j) { u32x2 w; w.x = cvtpk(v[j][0], v[j][1]); w.y = cvtpk(v[j][2], v[j][3]); *(GAS u32x2*)(dst + 4 * X.lane + 256 * j) = w; }
}

__device__ __forceinline__ void phase_norm1(const Params& p, Ctx& X, int l, const bool dm = false) {
    LAS int* cnt = (LAS int*)(X.lds + LDS_X); LAS int* rb = cnt + 16;
    if (l > 0) load_counts(p, X, l - 1, cnt, rb);
    const float* mod = (const float*)(p.ws + WS_MOD);
    bf16_t* xb = (bf16_t*)(p.ws + WS_XB);
    for (int t0 = X.gw; t0 < T; t0 += 2 * X.ngw) {
        const int t1 = t0 + X.ngw; const bool two = t1 < T; const int tt[2] = {t0, two ? t1 : t0};
        f32x4 v[2][8];
        if (l == 0) {
#pragma unroll
            for (int r = 0; r < 2; ++r) { const float* xr = p.x + (size_t)tt[r] * D + 4 * X.lane;
#pragma unroll
                for (int j = 0; j < 8; ++j) v[r][j] = __builtin_nontemporal_load((const GAS f32x4*)(xr + 256 * j)); }
        } else {
#pragma unroll
            for (int r = 0; r < 2; ++r) { const bf16_t* xr = xb + (size_t)tt[r] * D + 4 * X.lane;
#pragma unroll
                for (int j = 0; j < 8; ++j) { const u32x2 w = *(const GAS u32x2*)(xr + 256 * j); v[r][j] = (f32x4){bflo(w.x), bfhi(w.x), bflo(w.y), bfhi(w.y)}; } }
        }
        if (l > 0) {
            u32x2 ya[2][8], yc[2][8]; float w0[2], w1[2];
#pragma unroll
            for (int r = 0; r < 2; ++r) { const int* sl = (const int*)(p.ws + WS_SLOT) + (size_t)tt[r] * 8;
                const int e0 = sl[0], p0 = sl[1], e1 = sl[2], p1 = sl[3]; w0[r] = __int_as_float(sl[4]); w1[r] = __int_as_float(sl[5]);
                const bf16_t* y0 = (const bf16_t*)(p.ws + WS_Y) + (size_t)(rb[e0] + p0) * D + 4 * X.lane;
                const bf16_t* y1 = (const bf16_t*)(p.ws + WS_Y) + (size_t)(rb[e1] + p1) * D + 4 * X.lane;
#pragma unroll
                for (int j = 0; j < 8; ++j) { ya[r][j] = __builtin_nontemporal_load((const GAS u32x2*)(y0 + 256 * j)); yc[r][j] = __builtin_nontemporal_load((const GAS u32x2*)(y1 + 256 * j)); } }
#pragma unroll
            for (int r = 0; r < 2; ++r) { const int b = tt[r] >> 12;
                const float* gf = mod + ((size_t)(l - 1) * 2 + b) * 12288 + 5 * D + 4 * X.lane;
                f32x4 gq[8];
#pragma unroll
                for (int j = 0; j < 8; ++j) gq[j] = *(const GAS f32x4*)(gf + 256 * j);
                asm volatile("" ::: "memory");
#pragma unroll
                for (int j = 0; j < 8; ++j) { const f32x4 g = gq[j]; const u32x2 a = ya[r][j], c = yc[r][j];
                    v[r][j][0] += g[0] * (w0[r] * bflo(a.x) + w1[r] * bflo(c.x)); v[r][j][1] += g[1] * (w0[r] * bfhi(a.x) + w1[r] * bfhi(c.x));
                    v[r][j][2] += g[2] * (w0[r] * bflo(a.y) + w1[r] * bflo(c.y)); v[r][j][3] += g[3] * (w0[r] * bfhi(a.y) + w1[r] * bfhi(c.y)); } }
        }
#pragma unroll
        for (int r = 0; r < 2; ++r) { if (r == 1 && !two) break;
            if (l == DEPTH) { float* xo = p.out + (size_t)tt[r] * D + 4 * X.lane;
#pragma unroll
                for (int j = 0; j < 8; ++j) __builtin_nontemporal_store(v[r][j], (GAS f32x4*)(xo + 256 * j)); }
            else store_row_bf16(X, (dm ? (bf16_t*)(p.ws + WS_OCAT) : xb) + (size_t)tt[r] * D, v[r]);
            if (l < DEPTH) { const int b = tt[r] >> 12; const float* m = mod + ((size_t)l * 2 + b) * 12288;
                norm_mod2(X, v[r], (const float*)(p.ws + WS_MOD2 + 65536) + ((size_t)l * 2 + b) * D, m + 0 * D);
                store_row_bf16(X, (bf16_t*)(p.ws + (dm ? WS_OATT : WS_H)) + (size_t)tt[r] * D, v[r]); } }
    }
}
__device__ __forceinline__ void phase_prep1(const Params& p, Ctx& X, int l) {
    const bf16_t* proj = (const bf16_t*)(p.ws + WS_PROJ);
    for (int t = X.gw; t < T; t += X.ngw) {
        const u32x4 a = *(const GAS u32x4*)(proj + (size_t)t * INP + C_CQ + 8 * X.lane);
        float f[8] = {bflo(a.x), bfhi(a.x), bflo(a.y), bfhi(a.y), bflo(a.z), bfhi(a.z), bflo(a.w), bfhi(a.w)};
        float ss = 0.f;
#pragma unroll
        for (int i = 0; i < 8; ++i) ss += f[i] * f[i];
        float rstd = rsqrtf(wave_sum(ss) * (1.f / QL) + EPS);
        const float* g = p.q_lora_g + l * QL + 8 * X.lane;
        u32x4 o; o.x = cvtpk(f[0] * rstd * g[0], f[1] * rstd * g[1]); o.y = cvtpk(f[2] * rstd * g[2], f[3] * rstd * g[3]); o.z = cvtpk(f[4] * rstd * g[4], f[5] * rstd * g[5]); o.w = cvtpk(f[6] * rstd * g[6], f[7] * rstd * g[7]);
        *(GAS u32x4*)((bf16_t*)(p.ws + WS_CQN) + (size_t)t * QL + 8 * X.lane) = o;
        const u32x2 c = *(const GAS u32x2*)(proj + (size_t)t * INP + C_CKV + 4 * X.lane);
        float h[4] = {bflo(c.x), bfhi(c.x), bflo(c.y), bfhi(c.y)};
        ss = h[0] * h[0] + h[1] * h[1] + h[2] * h[2] + h[3] * h[3];
        rstd = rsqrtf(wave_sum(ss) * (1.f / KVL) + EPS);
        const float* g2 = p.kv_lora_g + l * KVL + 4 * X.lane;
        u32x2 o2; o2.x = cvtpk(h[0] * rstd * g2[0], h[1] * rstd * g2[1]); o2.y = cvtpk(h[2] * rstd * g2[2], h[3] * rstd * g2[3]);
        *(GAS u32x2*)((bf16_t*)(p.ws + WS_CKVN) + (size_t)t * KVL + 4 * X.lane) = o2;
    }
}
__device__ __forceinline__ void phase_prep2(const Params& p, Ctx& X, int l) {
    const bf16_t* proj = (const bf16_t*)(p.ws + WS_PROJ); const bf16_t* kvraw = (const bf16_t*)(p.ws + WS_KVRAW); bf16_t* kf = (bf16_t*)(p.ws + WS_KF);
    const float* ct = (const float*)(p.ws + WS_ROPE); const float* st = ct + SEQ * 32;
    const int lane = X.lane, hA = lane >> 4, dch = lane & 15, hR = lane >> 3, c8 = lane & 7;
    const float* kg = p.k_head_g + l * QK;
    const f32x4 gn0 = *(const GAS f32x4*)(kg + 8 * dch), gn1 = *(const GAS f32x4*)(kg + 8 * dch + 4), gr0 = *(const GAS f32x4*)(kg + 128 + 8 * c8), gr1 = *(const GAS f32x4*)(kg + 128 + 8 * c8 + 4);
    for (int t0 = X.gw; t0 < T; t0 += 4 * X.ngw) {
        int tt[4]; bool okr[4];
#pragma unroll
        for (int r = 0; r < 4; ++r) { okr[r] = t0 + r * X.ngw < T; tt[r] = okr[r] ? t0 + r * X.ngw : t0; }
        u32x4 rawA[4], rawB[4], rawR[4];
#pragma unroll
        for (int r = 0; r < 4; ++r) { const int t = tt[r];
            rawA[r] = *(const GAS u32x4*)(kvraw + (size_t)t * 2048 + hA * 256 + 8 * dch); rawB[r] = *(const GAS u32x4*)(kvraw + (size_t)t * 2048 + (hA + 4) * 256 + 8 * dch);
            rawR[r] = *(const GAS u32x4*)(proj + (size_t)t * INP + C_KR + 8 * c8); }
#pragma unroll
        for (int r = 0; r < 4; ++r) { if (!okr[r]) continue;
            const int t = tt[r], pos = t & (SEQ - 1);
            float a[8], bq[8], kr[8];
            { const u32x4 w = rawA[r]; a[0] = bflo(w.x); a[1] = bfhi(w.x); a[2] = bflo(w.y); a[3] = bfhi(w.y); a[4] = bflo(w.z); a[5] = bfhi(w.z); a[6] = bflo(w.w); a[7] = bfhi(w.w); }
            { const u32x4 w = rawB[r]; bq[0] = bflo(w.x); bq[1] = bfhi(w.x); bq[2] = bflo(w.y); bq[3] = bfhi(w.y); bq[4] = bflo(w.z); bq[5] = bfhi(w.z); bq[6] = bflo(w.w); bq[7] = bfhi(w.w); }
            { const u32x4 w = rawR[r]; kr[0] = bflo(w.x); kr[1] = bfhi(w.x); kr[2] = bflo(w.y); kr[3] = bfhi(w.y); kr[4] = bflo(w.z); kr[5] = bfhi(w.z); kr[6] = bflo(w.w); kr[7] = bfhi(w.w); }
            float sr = 0.f, sa = 0.f, sb = 0.f;
#pragma unroll
            for (int j = 0; j < 8; ++j) { sr += kr[j] * kr[j]; sa += a[j] * a[j]; sb += bq[j] * bq[j]; }
            sr += dpp_mov<0xB1>(sr); sr += dpp_mov<0x4E>(sr); sr += dpp_mov<0x141>(sr);
            sa += dpp_mov<0x128>(sa); sa += dpp_mov<0x124>(sa); sa += dpp_mov<0x122>(sa); sa += dpp_mov<0x121>(sa);
            sb += dpp_mov<0x128>(sb); sb += dpp_mov<0x124>(sb); sb += dpp_mov<0x122>(sb); sb += dpp_mov<0x121>(sb);
            const float rA = rsqrtf((sa + sr) * (1.f / QK) + EPS), rB = rsqrtf((sb + sr) * (1.f / QK) + EPS);
            { u32x4 o; o.x = cvtpk(a[0] * rA * gn0[0], a[1] * rA * gn0[1]); o.y = cvtpk(a[2] * rA * gn0[2], a[3] * rA * gn0[3]); o.z = cvtpk(a[4] * rA * gn1[0], a[5] * rA * gn1[1]); o.w = cvtpk(a[6] * rA * gn1[2], a[7] * rA * gn1[3]);
              *(GAS u32x4*)(kf + (size_t)t * 1536 + hA * QK + 8 * dch) = o; }
            { u32x4 o; o.x = cvtpk(bq[0] * rB * gn0[0], bq[1] * rB * gn0[1]); o.y = cvtpk(bq[2] * rB * gn0[2], bq[3] * rB * gn0[3]); o.z = cvtpk(bq[4] * rB * gn1[0], bq[5] * rB * gn1[1]); o.w = cvtpk(bq[6] * rB * gn1[2], bq[7] * rB * gn1[3]);
              *(GAS u32x4*)(kf + (size_t)t * 1536 + (hA + 4) * QK + 8 * dch) = o; }
            const float rsA = __int_as_float(__builtin_amdgcn_ds_bpermute(64 * (hR & 3), __float_as_int(rA))), rsB = __int_as_float(__builtin_amdgcn_ds_bpermute(64 * (hR & 3), __float_as_int(rB))); const float rs = hR < 4 ? rsA : rsB;
            const f32x4 c0 = *(const GAS f32x4*)(ct + (size_t)pos * 32 + 8 * (c8 & 3)), c1 = *(const GAS f32x4*)(ct + (size_t)pos * 32 + 8 * (c8 & 3) + 4);
            const f32x4 s0 = *(const GAS f32x4*)(st + (size_t)pos * 32 + 8 * (c8 & 3)), s1 = *(const GAS f32x4*)(st + (size_t)pos * 32 + 8 * (c8 & 3) + 4);
            float xo[8];
#pragma unroll
            for (int j = 0; j < 8; ++j) { const float x = kr[j] * (j < 4 ? gr0[j & 3] : gr1[j & 3]); const float pr = lane_xor<4>(x);
                const float c = j < 4 ? c0[j & 3] : c1[j & 3], sn = j < 4 ? s0[j & 3] : s1[j & 3];
                xo[j] = (c8 < 4 ? x * c - pr * sn : pr * sn + x * c) * rs; }
            { u32x4 o; o.x = cvtpk(xo[0], xo[1]); o.y = cvtpk(xo[2], xo[3]); o.z = cvtpk(xo[4], xo[5]); o.w = cvtpk(xo[6], xo[7]);
              *(GAS u32x4*)(kf + (size_t)t * 1536 + hR * QK + 128 + 8 * c8) = o; }
        }
    }
}
__device__ __forceinline__ void phase_onorm(const Params& p, Ctx& X, int l) {
    const bf16_t* oatt = (const bf16_t*)(p.ws + WS_OATT); bf16_t* ocat = (bf16_t*)(p.ws + WS_OCAT);
    for (int t0 = X.gw; t0 < T; t0 += 2 * X.ngw) {
        const int t1 = t0 + X.ngw; const bool two = t1 < T; const int tt[2] = {t0, two ? t1 : t0};
        u32x4 a[2][2][2];
#pragma unroll
        for (int r = 0; r < 2; ++r)
#pragma unroll
            for (int half = 0; half < 2; ++half)
#pragma unroll
                for (int j = 0; j < 2; ++j) a[r][half][j] = *(const GAS u32x4*)(oatt + (size_t)tt[r] * D + half * 1024 + 8 * X.lane + 512 * j);
#pragma unroll
        for (int r = 0; r < 2; ++r) { if (r == 1 && !two) break;
#pragma unroll
            for (int half = 0; half < 2; ++half) {
                const float* g = (half ? p.sb_out_g : p.mla_out_g) + l * 1024;
                float f[16];
#pragma unroll
                for (int j = 0; j < 2; ++j) { const u32x4 q = a[r][half][j];
                    f[8 * j + 0] = bflo(q.x); f[8 * j + 1] = bfhi(q.x); f[8 * j + 2] = bflo(q.y); f[8 * j + 3] = bfhi(q.y); f[8 * j + 4] = bflo(q.z); f[8 * j + 5] = bfhi(q.z); f[8 * j + 6] = bflo(q.w); f[8 * j + 7] = bfhi(q.w); }
                float ss = 0.f;
#pragma unroll
                for (int i = 0; i < 16; ++i) ss += f[i] * f[i];
                const float rstd = rsqrtf(wave_sum(ss) * (1.f / 1024) + EPS);
#pragma unroll
                for (int j = 0; j < 2; ++j) { const f32x4 g0 = *(const GAS f32x4*)(g + 8 * X.lane + 512 * j), g1 = *(const GAS f32x4*)(g + 8 * X.lane + 512 * j + 4); u32x4 o;
                    o.x = cvtpk(f[8 * j + 0] * rstd * g0[0], f[8 * j + 1] * rstd * g0[1]); o.y = cvtpk(f[8 * j + 2] * rstd * g0[2], f[8 * j + 3] * rstd * g0[3]);
                    o.z = cvtpk(f[8 * j + 4] * rstd * g1[0], f[8 * j + 5] * rstd * g1[1]); o.w = cvtpk(f[8 * j + 6] * rstd * g1[2], f[8 * j + 7] * rstd * g1[3]);
                    *(GAS u32x4*)(ocat + (size_t)tt[r] * D + half * 1024 + 8 * X.lane + 512 * j) = o; } } }
    }
}
__device__ __forceinline__ void route_pick(const float (&lg)[NE], const float* router_b, int& e0, int& e1, float& w0, float& w1) {
    float sc[NE], sel[NE];
#pragma unroll
    for (int e = 0; e < NE; ++e) { sc[e] = 1.f / (1.f + expf(-lg[e])); sel[e] = sc[e] + router_b[e]; }
    int gbest = 0; float gs_best = 0.f;
#pragma unroll
    for (int g = 0; g < 4; ++g) { const float a = sel[4 * g], bb = sel[4 * g + 1], c = sel[4 * g + 2], d = sel[4 * g + 3];
        const float hi1 = fmaxf(a, bb), lo1 = fminf(a, bb), hi2 = fmaxf(c, d), lo2 = fminf(c, d);
        const float top = fmaxf(hi1, hi2), second = fmaxf(fminf(hi1, hi2), fmaxf(lo1, lo2));
        const float gs = top + second;
        if (g == 0 || gs > gs_best) { gs_best = gs; gbest = g; } }
    float s4[4], c4[4];
#pragma unroll
    for (int i = 0; i < 4; ++i) { s4[i] = 0.f; c4[i] = 0.f; }
#pragma unroll
    for (int g = 0; g < 4; ++g)
#pragma unroll
        for (int i = 0; i < 4; ++i) if (gbest == g) { s4[i] = sel[4 * g + i]; c4[i] = sc[4 * g + i]; }
    int i1 = 0; float b1 = s4[0];
#pragma unroll
    for (int i = 1; i < 4; ++i) if (s4[i] > b1) { b1 = s4[i]; i1 = i; }
    int i2 = -1; float b2 = 0.f;
#pragma unroll
    for (int i = 0; i < 4; ++i) if (i != i1 && (i2 < 0 || s4[i] > b2)) { b2 = s4[i]; i2 = i; }
    float x1 = 0.f, x2 = 0.f;
#pragma unroll
    for (int i = 0; i < 4; ++i) { if (i == i1) x1 = c4[i]; if (i == i2) x2 = c4[i]; }
    const float inv = 1.f / (x1 + x2);
    e0 = gbest * 4 + i1; e1 = gbest * 4 + i2; w0 = x1 * inv; w1 = x2 * inv;
}
__device__ __forceinline__ void phase_norm2_route(const Params& p, Ctx& X, int l, const bool dm = false) {
    LAS float* rwT = (LAS float*)X.lds;
    LAS int* pk = (LAS int*)(X.lds + LDS_X);
    LAS float* lgs = (LAS float*)(X.lds + LDS_X + 1024) + X.wave * 64;
    { const char* src = (const char*)(p.ws + WS_RWT);
#pragma unroll
      for (int i = 0; i < 16; ++i) __builtin_amdgcn_global_load_lds((const unsigned*)(src + (size_t)(i * NTHR + X.tid) * 16), (LAS unsigned*)(X.lds + i * 8192 + X.wave * 1024), 16, 0, 0); }
    const float* mod = (const float*)(p.ws + WS_MOD);
    const int rows_per = ((T + X.G - 1) / X.G + 3) & ~3;
    const int t0 = X.blk * rows_per;
    const int lane = X.lane;
#pragma unroll 1
    for (int c0 = 0; c0 < rows_per; c0 += 4 * NWAVES) {
        const int rl0 = c0 + 4 * X.wave;
        int tt[4]; bool ok[4];
#pragma unroll
        for (int r = 0; r < 4; ++r) { ok[r] = (rl0 + r < rows_per) && (t0 + rl0 + r < T); tt[r] = ok[r] ? t0 + rl0 + r : (t0 < T ? t0 : 0); }
        f32x4 v[4][8];
#pragma unroll
        for (int r = 0; r < 4; ++r) { const bf16_t* xr = (const bf16_t*)(p.ws + WS_XB) + (size_t)tt[r] * D + 4 * lane;
#pragma unroll
            for (int j = 0; j < 8; ++j) { const u32x2 w = *(const GAS u32x2*)(xr + 256 * j); v[r][j] = (f32x4){bflo(w.x), bfhi(w.x), bflo(w.y), bfhi(w.y)}; } }
        float rstd[4];
#pragma unroll
        for (int r = 0; r < 4; ++r) { float ss = 0.f;
#pragma unroll
            for (int j = 0; j < 8; ++j) ss += (v[r][j][0] * v[r][j][0] + v[r][j][1] * v[r][j][1]) + (v[r][j][2] * v[r][j][2] + v[r][j][3] * v[r][j][3]);
            rstd[r] = rsqrtf(wave_sum_dpp(ss) * (1.f / D) + EPS); }
        { const int b0_ = tt[0] >> 12;
          const float* a2 = (const float*)(p.ws + WS_MOD2) + ((size_t)l * 2 + b0_) * D + 4 * lane; const float* sh2 = mod + ((size_t)l * 2 + b0_) * 12288 + 3 * D + 4 * lane;
#pragma unroll
          for (int j = 0; j < 8; ++j) { const f32x4 aa = *(const GAS f32x4*)(a2 + 256 * j), sh = *(const GAS f32x4*)(sh2 + 256 * j);
#pragma unroll
              for (int r = 0; r < 4; ++r) v[r][j] = v[r][j] * rstd[r] * aa + sh; } }
#pragma unroll
        for (int r = 0; r < 4; ++r) if (ok[r]) store_row_bf16(X, (bf16_t*)(p.ws + (dm ? WS_OCAT : WS_H)) + (size_t)tt[r] * D, v[r]);
        if (c0 == 0) { asm volatile("s_waitcnt vmcnt(0)" ::: "memory"); __syncthreads(); }
        float s[64];
#pragma unroll
        for (int i = 0; i < 64; ++i) s[i] = 0.f;
#pragma unroll
        for (int e = 0; e < NE; ++e) {
#pragma unroll
            for (int j = 0; j < 8; ++j) { const f32x4 w = *(const LAS f32x4*)(rwT + e * D + 4 * lane + 256 * j);
#pragma unroll
                for (int r = 0; r < 4; ++r) s[16 * r + e] += (v[r][j][0] * w[0] + v[r][j][1] * w[1]) + (v[r][j][2] * w[2] + v[r][j][3] * w[3]); }
            __builtin_amdgcn_sched_barrier(0); }
#pragma unroll
        for (int k = 0; k < 32; ++k) { auto rr = __builtin_amdgcn_permlane32_swap(__float_as_uint(s[k]), __float_as_uint(s[k + 32]), false, false); s[k] = __uint_as_float(rr[0]) + __uint_as_float(rr[1]); }
#pragma unroll
        for (int k = 0; k < 16; ++k) { auto rr = __builtin_amdgcn_permlane16_swap(__float_as_uint(s[k]), __float_as_uint(s[k + 16]), false, false); s[k] = __uint_as_float(rr[0]) + __uint_as_float(rr[1]); }
        { const bool b3 = (lane & 8) != 0, b2 = (lane & 4) != 0, b1 = (lane & 2) != 0, b0 = (lane & 1) != 0;
#pragma unroll
          for (int k = 0; k < 8; ++k) { const float keep = b3 ? s[k + 8] : s[k], send = b3 ? s[k] : s[k + 8]; s[k] = keep + lane_xor<8>(send); }
#pragma unroll
          for (int k = 0; k < 4; ++k) { const float keep = b2 ? s[k + 4] : s[k], send = b2 ? s[k] : s[k + 4]; s[k] = keep + lane_xor<4>(send); }
#pragma unroll
          for (int k = 0; k < 2; ++k) { const float keep = b1 ? s[k + 2] : s[k], send = b1 ? s[k] : s[k + 2]; s[k] = keep + lane_xor<2>(send); }
          { const float keep = b0 ? s[1] : s[0], send = b0 ? s[0] : s[1]; s[0] = keep + lane_xor<1>(send); } }
        lgs[lane] = s[0];
        asm volatile("s_waitcnt lgkmcnt(0)" ::: "memory");
        float lg[NE];
#pragma unroll
        for (int q = 0; q < 4; ++q) { const f32x4 t4 = *(const LAS f32x4*)(lgs + (lane >> 4) * 16 + 4 * q); lg[4 * q] = t4[0]; lg[4 * q + 1] = t4[1]; lg[4 * q + 2] = t4[2]; lg[4 * q + 3] = t4[3]; }
        int e0, e1; float w0, w1;
        route_pick(lg, p.router_b, e0, e1, w0, w1);
        const int rr_ = lane >> 4;
        if ((lane & 15) == 0 && rl0 + rr_ < 64) { const int rl = rl0 + rr_; pk[rl * 4 + 0] = e0; pk[rl * 4 + 1] = e1; pk[rl * 4 + 2] = __float_as_int(w0); pk[rl * 4 + 3] = __float_as_int(w1); }
        asm volatile("s_waitcnt lgkmcnt(0)" ::: "memory");
    }
    __syncthreads();
    const int nrows = (t0 + rows_per <= T) ? rows_per : (T - t0 > 0 ? T - t0 : 0);
    { const int e = X.tid >> 5, r = X.tid & 31, half = (X.tid >> 5) & 1;
      bool m0 = false, m1 = false; int k0 = 0, k1 = 0;
      if (r < nrows) { const int a = pk[r * 4 + 0], b = pk[r * 4 + 1]; m0 = (a == e) || (b == e); k0 = (a == e) ? 0 : 1; }
      if (r + 32 < nrows) { const int a = pk[(r + 32) * 4 + 0], b = pk[(r + 32) * 4 + 1]; m1 = (a == e) || (b == e); k1 = (a == e) ? 0 : 1; }
      const unsigned long long bal0 = __ballot(m0), bal1 = __ballot(m1);
      const unsigned h0 = half ? (unsigned)(bal0 >> 32) : (unsigned)bal0, h1 = half ? (unsigned)(bal1 >> 32) : (unsigned)bal1;
      const int n = __popc(h0) + __popc(h1);
      int base = 0;
      if (r == 0 && n) base = (int)__hip_atomic_fetch_add((unsigned*)(p.ws + WS_CTL) + CW_CNT + (dm ? 8192 : 0) + (l * 16 + e) * 64, (unsigned)n, __ATOMIC_RELAXED, __HIP_MEMORY_SCOPE_AGENT);
      { const int blo = __builtin_amdgcn_readlane(base, 0), bhi = __builtin_amdgcn_readlane(base, 32); base = half ? bhi : blo; }
      int* tok = (int*)(p.ws + (dm ? WS_KF : WS_TOK)) + e * T; int* slot = (int*)(p.ws + (dm ? WS_KF + MiB : WS_SLOT));
      const unsigned below = (1u << r) - 1u;
      if (m0) { const int t = t0 + r, pos = base + __popc(h0 & below);
          tok[pos] = t; slot[(size_t)t * 8 + 2 * k0] = e; slot[(size_t)t * 8 + 2 * k0 + 1] = pos; slot[(size_t)t * 8 + 4 + k0] = pk[r * 4 + 2 + k0]; }
      if (m1) { const int t = t0 + r + 32, pos = base + __popc(h0) + __popc(h1 & below);
          tok[pos] = t; slot[(size_t)t * 8 + 2 * k1] = e; slot[(size_t)t * 8 + 2 * k1 + 1] = pos; slot[(size_t)t * 8 + 4 + k1] = pk[(r + 32) * 4 + 2 + k1]; } }
}

__device__ __forceinline__ void phase_route2(const Params& p, Ctx& X, int l) {
    if (X.blk >= NE) return;
    const int e = X.blk; LAS int* wc = (LAS int*)(X.lds + LDS_X);
    int* slot = (int*)(p.ws + WS_SLOT); int* tok = (int*)(p.ws + WS_TOK) + e * T;
    const int tbeg = X.wave * (T / NWAVES);
    int n = 0;
    for (int c = 0; c < T / NWAVES / 64; ++c) { const int t = tbeg + c * 64 + X.lane; const bool m = (slot[(size_t)t * 8 + 0] == e) || (slot[(size_t)t * 8 + 2] == e); n += __popcll(__ballot(m)); }
    if (X.lane == 0) wc[X.wave] = n;
    __syncthreads();
    int base = 0, total = 0;
    for (int w = 0; w < NWAVES; ++w) { const int c = wc[w]; if (w < X.wave) base += c; total += c; }
    if (X.tid == 0) __hip_atomic_store((unsigned*)(p.ws + WS_CTL) + CW_CNT + (l * 16 + e) * 64, (unsigned)total, __ATOMIC_RELAXED, __HIP_MEMORY_SCOPE_AGENT);
    for (int c = 0; c < T / NWAVES / 64; ++c) { const int t = tbeg + c * 64 + X.lane; const int e0 = slot[(size_t)t * 8 + 0], e1 = slot[(size_t)t * 8 + 2]; const bool m = (e0 == e) || (e1 == e);
        const unsigned long long bal = __ballot(m); const int pos = base + __popcll(bal & ((1ull << X.lane) - 1ull));
        if (m) { tok[pos] = t; slot[(size_t)t * 8 + (e0 == e ? 1 : 3)] = pos; }
        base += __popcll(bal); }
}

__device__ __forceinline__ void phase_attn_naive(const Params& p, Ctx& X) {
    const bf16_t* qf = (const bf16_t*)(p.ws + WS_QF); const bf16_t* kf = (const bf16_t*)(p.ws + WS_KF); const bf16_t* kvraw = (const bf16_t*)(p.ws + WS_KVRAW);
    const bf16_t* proj = (const bf16_t*)(p.ws + WS_PROJ); bf16_t* oatt = (bf16_t*)(p.ws + WS_OATT);
    LAS float* qs = (LAS float*)(X.lds + X.wave * 2048); LAS float* ps = qs + 256;
    const int lane = X.lane;
    for (int it = X.gw; it < NB * NH * SEQ; it += X.ngw) {
        const int t = it % SEQ, h = (it / SEQ) % NH, b = it / (SEQ * NH);
        const bf16_t* q = qf + (size_t)(b * SEQ + t) * 1536 + h * QK;
        qs[lane] = bf2f(q[lane]); qs[64 + lane] = bf2f(q[64 + lane]); qs[128 + lane] = bf2f(q[128 + lane]);
        const int nk = 64 * ((t >> 6) + 1);
        float m = -1e30f, lsum = 0.f, o0 = 0.f, o1 = 0.f;
        for (int kb = 0; kb < nk; kb += 64) {
            const bf16_t* kr = kf + (size_t)(b * SEQ + kb + lane) * 1536 + h * QK; float s = 0.f;
#pragma unroll 4
            for (int d8 = 0; d8 < 24; ++d8) { const u32x4 a = *(const GAS u32x4*)(kr + 8 * d8); const f32x4 q0 = *(const LAS f32x4*)(qs + 8 * d8), q1 = *(const LAS f32x4*)(qs + 8 * d8 + 4);
                s += bflo(a.x) * q0[0] + bfhi(a.x) * q0[1] + bflo(a.y) * q0[2] + bfhi(a.y) * q0[3] + bflo(a.z) * q1[0] + bfhi(a.z) * q1[1] + bflo(a.w) * q1[2] + bfhi(a.w) * q1[3]; }
            const float mn = fmaxf(m, wave_max(s)); const float al = exp2f(m - mn); const float pe = exp2f(s - mn);
            lsum = lsum * al + wave_sum(pe); o0 *= al; o1 *= al; m = mn;
            ps[lane] = pe;
            const bf16_t* vb = kvraw + (size_t)(b * SEQ + kb) * 2048 + h * 256 + 128;
#pragma unroll 8
            for (int j = 0; j < 64; ++j) { const float pj = ps[j]; o0 += pj * bf2f(vb[(size_t)j * 2048 + lane]); o1 += pj * bf2f(vb[(size_t)j * 2048 + 64 + lane]); }
        }
        const float il = 1.f / lsum;
        bf16_t* o = oatt + (size_t)(b * SEQ + t) * D + h * DV;
        o[lane] = f2bf(o0 * il); o[64 + lane] = f2bf(o1 * il);
    }
    for (int it = X.gw; it < NB * NH * SEQ; it += X.ngw) {
        const int t = it % SEQ, h = (it / SEQ) % NH, b = it / (SEQ * NH);
        const bf16_t* q = proj + (size_t)(b * SEQ + t) * INP + C_SQ + h * 128;
        qs[lane] = bf2f(q[lane]); qs[64 + lane] = bf2f(q[64 + lane]);
        float carry = 1.f, o0 = 0.f, o1 = 0.f;
        for (int kb = (t > 0) ? 64 * ((t - 1) >> 6) : -64; kb >= 0; kb -= 64) {
            const int j = kb + lane; const bool valid = j < t;
            const bf16_t* kr = proj + (size_t)(b * SEQ + j) * INP + C_SK + h * 128; float s = 0.f;
#pragma unroll 4
            for (int d8 = 0; d8 < 16; ++d8) { const u32x4 a = *(const GAS u32x4*)(kr + 8 * d8); const f32x4 q0 = *(const LAS f32x4*)(qs + 8 * d8), q1 = *(const LAS f32x4*)(qs + 8 * d8 + 4);
                s += bflo(a.x) * q0[0] + bfhi(a.x) * q0[1] + bflo(a.y) * q0[2] + bfhi(a.y) * q0[3] + bflo(a.z) * q1[0] + bfhi(a.z) * q1[1] + bflo(a.w) * q1[2] + bfhi(a.w) * q1[3]; }
            const float e = valid ? exp2f(s) : 0.f; const float r = 1.f / (1.f + e);
            float sp = r;
#pragma unroll
            for (int off = 1; off < 64; off <<= 1) { const float tmp = __shfl_down(sp, off); if (lane + off < 64) sp *= tmp; }
            const float a = e * sp * carry;
            carry *= __shfl(sp, 0);
            ps[lane] = a;
            const bf16_t* vb = proj + (size_t)(b * SEQ + kb) * INP + C_SV + h * 128;
#pragma unroll 8
            for (int jj = 0; jj < 64; ++jj) { const float pj = ps[jj]; o0 += pj * bf2f(vb[(size_t)jj * INP + lane]); o1 += pj * bf2f(vb[(size_t)jj * INP + 64 + lane]); }
        }
        bf16_t* o = oatt + (size_t)(b * SEQ + t) * D + 1024 + h * 128;
        o[lane] = f2bf(o0); o[64 + lane] = f2bf(o1);
    }
}


namespace att {
constexpr int SHM_V = 64 * 128 * 2;
#define SBAR() __builtin_amdgcn_sched_barrier(0)
#define KSWZ(row, colB) ((row) * 256 + ((colB) ^ (((row) & 7) << 4)))
__device__ __forceinline__ int v_st(int k, int c) { const int kk = (k & ~0xC) | ((k & 4) << 1) | ((k & 8) >> 1); return ((kk >> 3) * 4 + (c >> 5)) * 512 + ((kk & 7) * 32 + (c & 31)) * 2; }
__device__ __forceinline__ int v_rd_base(int lane) { return ((lane & 3) << 3) | (((lane >> 2) & 3) << 6) | (((lane >> 4) & 1) << 5) | (((lane >> 5) & 1) << 8); }
constexpr int v_rd_off(int d0, int ks, int half) { return d0 * 512 + ks * 4096 + half * 2048; }
__device__ __forceinline__ int crow(int r, int hi) { return (r & 3) + 8 * (r >> 2) + 4 * hi; }
__device__ __forceinline__ bf16x8 load8(const bf16_t* p) { return *(const GAS bf16x8*)p; }

struct Blk { const bf16_t* Q; const bf16_t* K; const bf16_t* V; bf16_t* O; int P0; const float* qg; const float* ct; float* oss; int tb, nt, split, ldo; float* pml; unsigned* part; unsigned* flag; };
template <bool MLA> struct Seam { bf16x8 qr[MLA ? 12 : 8]; bf16x8 st_v0, st_v1; bf16x8 st_k[MLA ? 3 : 2]; };

__device__ __forceinline__ void mask_tile(f32x16& p0, f32x16& p1, int dq) {
    const float NEG = -__builtin_inff();
#pragma unroll
    for (int r = 0; r < 16; ++r) { const int c = (r & 3) + 8 * (r >> 2); if (dq - c < 0) p0[r] = NEG; if (dq - c - 32 < 0) p1[r] = NEG; }
}
#define PK4(P, B_, OUT) do { unsigned a0 = cvtpk(P[B_+0], P[B_+1]), a1 = cvtpk(P[B_+2], P[B_+3]);                          \
        unsigned b0 = cvtpk(P[B_+4], P[B_+5]), b1 = cvtpk(P[B_+6], P[B_+7]);                                             \
        auto r0 = __builtin_amdgcn_permlane32_swap(a0, b0, false, false); auto r1 = __builtin_amdgcn_permlane32_swap(a1, b1, false, false); \
        u32x4 w = {r0[0], r1[0], r0[1], r1[1]}; OUT = *reinterpret_cast<bf16x8*>(&w); } while (0)
__device__ __forceinline__ void partialSM(f32x16& p0, f32x16& p1, float& m_reg, float& mn, float& alpha) {
    float pmax = p0[0];
#pragma unroll
    for (int r = 1; r < 16; ++r) pmax = fmaxf(pmax, p0[r]);
#pragma unroll
    for (int r = 0; r < 16; ++r) pmax = fmaxf(pmax, p1[r]);
    { auto rr = __builtin_amdgcn_permlane32_swap(__float_as_uint(pmax), __float_as_uint(pmax), false, false); pmax = fmaxf(__uint_as_float(rr[0]), __uint_as_float(rr[1])); }
    if (__builtin_expect(__all((pmax - m_reg) <= 11.54f), 1)) { mn = m_reg; alpha = 1.f; }
    else { mn = fmaxf(m_reg, pmax); alpha = __builtin_amdgcn_exp2f(m_reg - mn); m_reg = mn; }
#pragma unroll
    for (int r = 0; r < 16; ++r) p0[r] = p0[r] - mn;
#pragma unroll
    for (int r = 0; r < 16; ++r) p1[r] = p1[r] - mn;
#pragma unroll
    for (int r = 0; r < 16; ++r) p0[r] = __builtin_amdgcn_exp2f(p0[r]);
}
__device__ __forceinline__ void finishSM(f32x16& p0, f32x16& p1, float alpha, float& l_reg, bf16x8& pa0, bf16x8& pa1, bf16x8& pa2, bf16x8& pa3) {
#pragma unroll
    for (int r = 0; r < 16; ++r) p1[r] = __builtin_amdgcn_exp2f(p1[r]);
    float ps = 0;
#pragma unroll
    for (int r = 0; r < 16; ++r) ps += p0[r];
#pragma unroll
    for (int r = 0; r < 16; ++r) ps += p1[r];
    { auto rr = __builtin_amdgcn_permlane32_swap(__float_as_uint(ps), __float_as_uint(ps), false, false); ps = __uint_as_float(rr[0]) + __uint_as_float(rr[1]); }
    l_reg = l_reg * alpha + ps;
    PK4(p0, 0, pa0); PK4(p0, 8, pa1); PK4(p1, 0, pa2); PK4(p1, 8, pa3);
}
__device__ __forceinline__ void sb_part(f32x16& p0, f32x16& p1) {
#pragma unroll
    for (int r = 0; r < 16; ++r) p0[r] = __builtin_amdgcn_exp2f(fminf(p0[r], 100.f));
#pragma unroll
    for (int r = 0; r < 16; ++r) p1[r] = __builtin_amdgcn_exp2f(fminf(p1[r], 100.f));
}
__device__ __forceinline__ void sb_block(f32x16& p, float& carry, int hi) {
    float s[16];
#pragma unroll
    for (int r = 0; r < 16; ++r) s[r] = __builtin_amdgcn_rcpf(1.f + p[r]);
#pragma unroll
    for (int g = 0; g < 4; ++g) { s[4 * g + 2] *= s[4 * g + 3]; s[4 * g + 1] *= s[4 * g + 2]; s[4 * g] *= s[4 * g + 1]; }
    float lo[4], hh[4];
#pragma unroll
    for (int g = 0; g < 4; ++g) { auto rr = __builtin_amdgcn_permlane32_swap(__float_as_uint(s[4 * g]), __float_as_uint(s[4 * g]), false, false); lo[g] = __uint_as_float(rr[0]); hh[g] = __uint_as_float(rr[1]); }
    const float X7 = carry, X6 = X7 * hh[3], X5 = X6 * lo[3], X4 = X5 * hh[2], X3 = X4 * lo[2], X2 = X3 * hh[1], X1 = X2 * lo[1], X0 = X1 * hh[0];
    carry = X0 * lo[0];
    const float m0 = hi ? X1 : X0, m1 = hi ? X3 : X2, m2 = hi ? X5 : X4, m3 = hi ? X7 : X6;
#pragma unroll
    for (int i = 0; i < 4; ++i) { p[i] = p[i] * (s[i] * m0); p[4 + i] = p[4 + i] * (s[4 + i] * m1); p[8 + i] = p[8 + i] * (s[8 + i] * m2); p[12 + i] = p[12 + i] * (s[12 + i] * m3); }
}
__device__ __forceinline__ void sb_finish(f32x16& p0, f32x16& p1, float& carry, int hi, bf16x8& pa0, bf16x8& pa1, bf16x8& pa2, bf16x8& pa3) {
    sb_block(p1, carry, hi); sb_block(p0, carry, hi);
    PK4(p0, 0, pa0); PK4(p0, 8, pa1); PK4(p1, 0, pa2); PK4(p1, 8, pa3);
}
template <bool MLA, int KB>
__device__ __forceinline__ void qkt(f32x16& p0, f32x16& p1, const LAS char* K_lds, int r32, int hi, const bf16x8* qr, const LAS bf16x8* qx, bool act) {
    constexpr int SHM_K = 64 * (MLA ? 192 : 128) * 2, NQ = MLA ? 12 : 8, PITCH = MLA ? 384 : 256, QREG = MLA ? 5 : 8;
    if (!act) { const float NEG = -__builtin_inff();
#pragma unroll
        for (int r = 0; r < 16; ++r) { p0[r] = NEG; p1[r] = NEG; } return; }
    p0 = f32x16{}; p1 = f32x16{};
    const LAS char* kb[4];
#pragma unroll
    for (int dd = 0; dd < 4; ++dd) kb[dd] = K_lds + KB * SHM_K + (MLA ? (r32 * 384 + (((2 * dd + hi) ^ ((r32 >> 1) & 7)) << 4)) : KSWZ(r32, (dd * 16 + hi * 8) * 2));
#pragma unroll
    for (int d0 = 0; d0 < NQ; ++d0) { const LAS char* a = kb[d0 & 3] + (d0 >> 2) * 128;
        bf16x8 b0 = *reinterpret_cast<const LAS bf16x8*>(a);
        bf16x8 b1 = *reinterpret_cast<const LAS bf16x8*>(a + 32 * PITCH);
        const bf16x8 q = (MLA && d0 >= QREG) ? qx[(d0 - QREG) * 64] : qr[d0 < QREG ? d0 : 0];
        p0 = __builtin_amdgcn_mfma_f32_32x32x16_bf16(b0, q, p0, 0, 0, 0);
        p1 = __builtin_amdgcn_mfma_f32_32x32x16_bf16(b1, q, p1, 0, 0, 0); }
}
template <int VB>
__device__ __forceinline__ void pv_tile(f32x16* o, int vb0, bf16x8 pa0, bf16x8 pa1, bf16x8 pa2, bf16x8 pa3, bool act) {
    if (!act) return;
#define TRRD(dst, off) asm volatile("ds_read_b64_tr_b16 %0, %1 offset:%2" : "=&v"(dst) : "v"(vb0), "i"(off) : "memory")
#define PV_D0(d0) do { s16x4 l0, l1, l2, l3, h0, h1, h2, h3; constexpr int b_ = VB * SHM_V + v_rd_off(d0, 0, 0); \
        TRRD(l0, b_); TRRD(h0, b_ + 2048); TRRD(l1, b_ + 4096); TRRD(h1, b_ + 6144); TRRD(l2, b_ + 8192); TRRD(h2, b_ + 10240); TRRD(l3, b_ + 12288); TRRD(h3, b_ + 14336); \
        asm volatile("s_waitcnt lgkmcnt(0)" ::: "memory"); SBAR();   \
        o[d0] = __builtin_amdgcn_mfma_f32_32x32x16_bf16(pa0, (bf16x8){l0[0], l0[1], l0[2], l0[3], h0[0], h0[1], h0[2], h0[3]}, o[d0], 0, 0, 0);   \
        o[d0] = __builtin_amdgcn_mfma_f32_32x32x16_bf16(pa1, (bf16x8){l1[0], l1[1], l1[2], l1[3], h1[0], h1[1], h1[2], h1[3]}, o[d0], 0, 0, 0);   \
        o[d0] = __builtin_amdgcn_mfma_f32_32x32x16_bf16(pa2, (bf16x8){l2[0], l2[1], l2[2], l2[3], h2[0], h2[1], h2[2], h2[3]}, o[d0], 0, 0, 0);   \
        o[d0] = __builtin_amdgcn_mfma_f32_32x32x16_bf16(pa3, (bf16x8){l3[0], l3[1], l3[2], l3[3], h3[0], h3[1], h3[2], h3[3]}, o[d0], 0, 0, 0); } while (0)
    PV_D0(0); PV_D0(1); PV_D0(2); PV_D0(3);
#undef PV_D0
#undef TRRD
}

constexpr int QG_LDS_OFF = 142336;
template <bool MLA> struct Geo {
    static constexpr int DQK = MLA ? 192 : 128, SHM_K = 64 * DQK * 2, LDQ = MLA ? 1536 : INP, LDK = LDQ, LDV = MLA ? 2048 : INP, LDO = D;
    static constexpr int QX_OFF = 2 * SHM_V + 2 * SHM_K + NWAVES * 64 * 4, LDS_NEED = QX_OFF + (MLA ? NWAVES * 7168 : 0);
};
#define ATT_VMW() asm volatile("s_waitcnt vmcnt(0)" ::: "memory")
#define ATT_VMWN(n) asm volatile("s_waitcnt vmcnt(%0)" :: "i"(n) : "memory")
template <bool MLA> __device__ __forceinline__ int first_kb(const Blk& c) { return MLA ? c.tb * 64 : (c.P0 / 64 + 3) * 64; }

template <bool MLA> struct Stg {
    int vg0, vg1, vst0, vst1, kg, kw;
    __device__ __forceinline__ void init(int tid) {
        const int sr = tid >> 4, sc = (tid & 15) * 8;
        vg0 = sr * Geo<MLA>::LDV + sc; vg1 = (32 + sr) * Geo<MLA>::LDV + sc; vst0 = v_st(sr, sc); vst1 = v_st(32 + sr, sc);
        if (MLA) { const int krow = tid >> 3, kch = tid & 7; kg = krow * Geo<MLA>::LDK + kch * 8; kw = krow * 384 + ((kch ^ ((krow >> 1) & 7)) << 4); }
        else { kg = sr * Geo<MLA>::LDK + sc; kw = KSWZ(sr, sc * 2); }
    }
};
#define ATT_SLOAD(Kp, Vp, kb_) do { S.st_v0 = load8((Vp) + (size_t)(kb_) * G::LDV + G_.vg0); S.st_v1 = load8((Vp) + (size_t)(kb_) * G::LDV + G_.vg1);                 \
        if (MLA) { S.st_k[0] = load8((Kp) + (size_t)(kb_) * G::LDK + G_.kg); S.st_k[1] = load8((Kp) + (size_t)(kb_) * G::LDK + G_.kg + 64); S.st_k[MLA ? 2 : 0] = load8((Kp) + (size_t)(kb_) * G::LDK + G_.kg + 128); } \
        else { S.st_k[0] = load8((Kp) + (size_t)(kb_) * G::LDK + G_.kg); S.st_k[1] = load8((Kp) + (size_t)((kb_) + 32) * G::LDK + G_.kg); } } while (0)
#define ATT_SWRITE_K(bf) do { if (MLA) { *(LAS bf16x8*)(K_lds + (bf) * G::SHM_K + G_.kw) = S.st_k[0]; *(LAS bf16x8*)(K_lds + (bf) * G::SHM_K + G_.kw + 128) = S.st_k[1]; *(LAS bf16x8*)(K_lds + (bf) * G::SHM_K + G_.kw + 256) = S.st_k[MLA ? 2 : 0]; } \
        else { *(LAS bf16x8*)(K_lds + (bf) * G::SHM_K + G_.kw) = S.st_k[0]; *(LAS bf16x8*)(K_lds + (bf) * G::SHM_K + G_.kw + 32 * 256) = S.st_k[1]; } } while (0)
#define ATT_SWRITE_V(bf) do { *(LAS bf16x8*)(V_lds + (bf) * SHM_V + G_.vst0) = S.st_v0; *(LAS bf16x8*)(V_lds + (bf) * SHM_V + G_.vst1) = S.st_v1; } while (0)

template <bool MLA>
__device__ __forceinline__ void attn_prime(const Blk& cur, LAS char* lds, Seam<MLA>& S, const int tid) {
    typedef Geo<MLA> G;
    const int wid = __builtin_amdgcn_readfirstlane(tid >> 6), lane = tid & 63, r32 = lane & 31, hi = lane >> 5;
    Stg<MLA> G_; G_.init(tid);
    LAS char* K_lds = lds + 2 * SHM_V;
    const int kb0 = first_kb<MLA>(cur);
#pragma unroll
    for (int d0 = 0; d0 < G::DQK / 16; ++d0) S.qr[d0] = load8(cur.Q + (size_t)(wid * 32 + r32) * G::LDQ + d0 * 16 + hi * 8);
    ATT_SLOAD(cur.K, cur.V, kb0);
    if constexpr (MLA) {
        const LAS float* qgl = (const LAS float*)(lds + QG_LDS_OFF);
#define UNPK8(dst, src) do { const u32x4 w_ = *reinterpret_cast<const u32x4*>(&(src)); dst[0] = bflo(w_.x); dst[1] = bfhi(w_.x); dst[2] = bflo(w_.y); dst[3] = bfhi(w_.y); dst[4] = bflo(w_.z); dst[5] = bfhi(w_.z); dst[6] = bflo(w_.w); dst[7] = bfhi(w_.w); } while (0)
#define PK8(dst, src) do { u32x4 w_; w_.x = cvtpk(src[0], src[1]); w_.y = cvtpk(src[2], src[3]); w_.z = cvtpk(src[4], src[5]); w_.w = cvtpk(src[6], src[7]); dst = *reinterpret_cast<bf16x8*>(&w_); } while (0)
        const int pos = cur.P0 + wid * 32 + r32;
        f32x4 rc[2][2], rsn[2][2];
#pragma unroll
        for (int i = 0; i < 2; ++i) { const float* cp = cur.ct + (size_t)pos * 32 + i * 16 + hi * 8; const float* sp = cp + SEQ * 32;
            rc[i][0] = *(const GAS f32x4*)cp; rc[i][1] = *(const GAS f32x4*)(cp + 4); rsn[i][0] = *(const GAS f32x4*)sp; rsn[i][1] = *(const GAS f32x4*)(sp + 4); }
        float ss = 0.f;
#pragma unroll
        for (int d0 = 0; d0 < 12; ++d0) { float f[8]; UNPK8(f, S.qr[d0]);
#pragma unroll
            for (int j = 0; j < 8; ++j) ss += f[j] * f[j]; }
        { auto rr = __builtin_amdgcn_permlane32_swap(__float_as_uint(ss), __float_as_uint(ss), false, false); ss = __uint_as_float(rr[0]) + __uint_as_float(rr[1]); }
        const float rs = rsqrtf(ss * (1.f / QK) + EPS) * QSCALE_MLA;
#pragma unroll
        for (int d0 = 0; d0 < 8; ++d0) { float f[8]; UNPK8(f, S.qr[d0]); const f32x4 g0 = *(const LAS f32x4*)(qgl + d0 * 16 + hi * 8), g1 = *(const LAS f32x4*)(qgl + d0 * 16 + hi * 8 + 4);
#pragma unroll
            for (int j = 0; j < 4; ++j) { f[j] *= rs * g0[j]; f[4 + j] *= rs * g1[j]; }
            PK8(S.qr[d0], f); asm volatile("" ::: "memory"); }
#pragma unroll
        for (int d0 = 8; d0 < 10; ++d0) { float x1[8], x2[8]; UNPK8(x1, S.qr[d0]); UNPK8(x2, S.qr[d0 + 2]);
            const f32x4 g0 = *(const LAS f32x4*)(qgl + d0 * 16 + hi * 8), g1 = *(const LAS f32x4*)(qgl + d0 * 16 + hi * 8 + 4), h0 = *(const LAS f32x4*)(qgl + (d0 + 2) * 16 + hi * 8), h1 = *(const LAS f32x4*)(qgl + (d0 + 2) * 16 + hi * 8 + 4);
            const f32x4 c0 = rc[d0 - 8][0], c1 = rc[d0 - 8][1], s0 = rsn[d0 - 8][0], s1 = rsn[d0 - 8][1];
#pragma unroll
            for (int j = 0; j < 4; ++j) { const float a = x1[j] * rs * g0[j], bb = x2[j] * rs * h0[j]; x1[j] = a * c0[j] - bb * s0[j]; x2[j] = a * s0[j] + bb * c0[j];
                const float a2 = x1[4 + j] * rs * g1[j], b2 = x2[4 + j] * rs * h1[j]; x1[4 + j] = a2 * c1[j] - b2 * s1[j]; x2[4 + j] = a2 * s1[j] + b2 * c1[j]; }
            PK8(S.qr[d0], x1); PK8(S.qr[d0 + 2], x2); asm volatile("" ::: "memory"); }
#undef UNPK8
#undef PK8
    }
    ATT_VMW(); ATT_SWRITE_K(0);
    __syncthreads();
}
template <bool MLA>
__device__ __forceinline__ void attn_block(const Blk& cur, LAS char* lds, Seam<MLA>& S, const int tid) {
    typedef Geo<MLA> G;
    const int wid = __builtin_amdgcn_readfirstlane(tid >> 6), lane = tid & 63, r32 = lane & 31, hi = lane >> 5;
    const int NT = MLA ? cur.nt : cur.P0 / 64 + 4;
    const int qlo = cur.P0 + wid * 32, qm = qlo + r32 - 4 * hi - 1;
    LAS char* V_lds = lds; LAS char* K_lds = lds + 2 * SHM_V;
    LAS float* wsl = (LAS float*)(lds + 2 * SHM_V + 2 * G::SHM_K) + wid * 64; LAS float* li_l = wsl; LAS float* al_l = wsl + 32;
    float m_reg = -1e30f, l_reg = 0.f, carry = 1.f; f32x16 o[4] = {};
    Stg<MLA> G_; G_.init(tid);
    const int vb0 = (int)(size_t)V_lds + v_rd_base(lane);
    const bf16_t* Kh = cur.K; const bf16_t* Vh = cur.V;
#define RESC(a) do { if (MLA) { if (__any((a) < 1.f)) { if (hi == 0) al_l[r32] = (a); asm volatile("s_waitcnt lgkmcnt(0)" ::: "memory");              \
                     for (int d_ = 0; d_ < 4; ++d_) for (int r = 0; r < 16; ++r) o[d_][r] *= al_l[crow(r, hi)]; } } } while (0)
#define KBASE(t) (MLA ? (cur.tb + (t)) * 64 : (NT - 1 - (t)) * 64)
#define ACT(t) (MLA ? (KBASE(t) <= qlo) : (!alldone && KBASE(t) <= qlo + 30))
#define MASKT(P0_, P1_, t) do { if (!MLA) { const int kb_ = KBASE(t); if (ACT(t) && kb_ + 63 >= qlo) mask_tile(P0_, P1_, qm - kb_); } } while (0)
#define PART(P0_, P1_, mnX, alX) do { if (MLA) partialSM(P0_, P1_, m_reg, mnX, alX); else sb_part(P0_, P1_); } while (0)
#define FINISH(P0_, P1_, alY) do { if (MLA) finishSM(P0_, P1_, alY, l_reg, pa0, pa1, pa2, pa3); else sb_finish(P0_, P1_, carry, hi, pa0, pa1, pa2, pa3); } while (0)
    f32x16 pA0, pA1, pB0, pB1; float mnA = 0.f, mnB = 0.f, alA = 1.f, alB = 1.f; bf16x8 pa0, pa1, pa2, pa3;
    LAS int* dflag = (LAS int*)(lds + G::QX_OFF); bool alldone = false;
#define SB_PUB(tp) do { if (!MLA) { const bool dn_ = ACT(tp) && ACT((tp) - 2) && __all(carry < 1.0e-6f); if (lane == 0) dflag[wid] = dn_ ? 1 : 0; } } while (0)
#define SB_CHK() do { if (!MLA) { const u32x4 f0_ = *(const LAS u32x4*)dflag, f1_ = *(const LAS u32x4*)(dflag + 4); \
        alldone = (f0_.x & f0_.y & f0_.z & f0_.w & f1_.x & f1_.y & f1_.z & f1_.w) != 0u; } } while (0)
    LAS bf16x8* qx = (LAS bf16x8*)(lds + G::QX_OFF) + wid * 448 + lane;
    if (MLA) {
#pragma unroll
        for (int i = 0; i < 7; ++i) qx[i * 64] = S.qr[(MLA ? 5 : 0) + i]; }
    ATT_SWRITE_V(0); SBAR();
    ATT_SLOAD(Kh, Vh, KBASE(1));
    SBAR(); qkt<MLA, 0>(pA0, pA1, K_lds, r32, hi, S.qr, qx, ACT(0));
    MASKT(pA0, pA1, 0); PART(pA0, pA1, mnA, alA);
    ATT_VMW(); ATT_SWRITE_V(1); ATT_SWRITE_K(1);
    __syncthreads();
#define HALF_STEP(PX0, PX1, mnX, alX, PY0, PY1, alY, t, KB, VB, SB_) do {                                                      \
        SBAR(); qkt<MLA, KB>(PX0, PX1, K_lds, r32, hi, S.qr, qx, ACT(t));                                                         \
        FINISH(PY0, PY1, alY); SBAR(); SB_PUB((t) - 1);                                                                       \
        if ((t) + 1 < NT && !alldone) { ATT_SLOAD(Kh, Vh, KBASE((t) + 1)); SBAR(); }                                          \
        pv_tile<VB>(o, vb0, pa0, pa1, pa2, pa3, ACT((t) - 1)); MASKT(PX0, PX1, (t)); PART(PX0, PX1, mnX, alX);                \
        __syncthreads(); SB_CHK();                                                                                            \
        if ((t) + 1 < NT && !alldone) { ATT_VMW(); ATT_SWRITE_V(SB_); ATT_SWRITE_K(SB_); }                                    \
        RESC(alX); __syncthreads(); } while (0)
    for (int t = 1; t + 1 < NT && !alldone; t += 2) {
        HALF_STEP(pB0, pB1, mnB, alB, pA0, pA1, alA, t, 1, 0, 0);
        HALF_STEP(pA0, pA1, mnA, alA, pB0, pB1, alB, t + 1, 0, 1, 1);
    }
    SBAR(); qkt<MLA, 1>(pB0, pB1, K_lds, r32, hi, S.qr, qx, ACT(NT - 1)); SBAR();
    FINISH(pA0, pA1, alA); SBAR();
    pv_tile<0>(o, vb0, pa0, pa1, pa2, pa3, ACT(NT - 2));
    MASKT(pB0, pB1, NT - 1); PART(pB0, pB1, mnB, alB); __syncthreads(); RESC(alB);
    FINISH(pB0, pB1, alB); SBAR(); pv_tile<1>(o, vb0, pa0, pa1, pa2, pa3, ACT(NT - 1));
    if constexpr (MLA) {
        if (cur.split == 1) {
            if (tid == 0) { while (__hip_atomic_load(cur.flag, __ATOMIC_RELAXED, __HIP_MEMORY_SCOPE_AGENT) == 0u) __builtin_amdgcn_s_sleep(4); }
            if (wid == 0) { __builtin_amdgcn_fence(__ATOMIC_ACQUIRE, "agent"); asm volatile("s_waitcnt vmcnt(0)" ::: "memory"); }
            __syncthreads();
            const f32x2 ml2 = *(const GAS f32x2*)(cur.pml + (size_t)(wid * 32 + r32) * 2);
            const float M = fmaxf(m_reg, ml2[0]), w1 = __builtin_amdgcn_exp2f(m_reg - M), w2 = ml2[1] * __builtin_amdgcn_exp2f(ml2[0] - M);
            l_reg = l_reg * w1 + w2;
            if (hi == 0) { li_l[r32] = w1; al_l[r32] = w2; } asm volatile("s_waitcnt lgkmcnt(0)" ::: "memory");
            const GAS u32x4* pp = (const GAS u32x4*)(cur.part + (size_t)(wid * 64 + lane) * 32);
#pragma unroll
            for (int q = 0; q < 8; ++q) { const u32x4 w = pp[q]; const int d0 = q >> 1, rb = (q & 1) * 8;
                const unsigned ww[4] = {w.x, w.y, w.z, w.w};
#pragma unroll
                for (int i = 0; i < 4; ++i) { const int ra = rb + 2 * i, rc = ra + 1;
                    o[d0][ra] = o[d0][ra] * li_l[crow(ra, hi)] + bflo(ww[i]) * al_l[crow(ra, hi)];
                    o[d0][rc] = o[d0][rc] * li_l[crow(rc, hi)] + bfhi(ww[i]) * al_l[crow(rc, hi)]; } }
            asm volatile("s_waitcnt lgkmcnt(0)" ::: "memory"); } }
    float rli[16];
    if (MLA) { if (hi == 0) li_l[r32] = l_reg; asm volatile("s_waitcnt lgkmcnt(0)" ::: "memory");
#pragma unroll
        for (int r = 0; r < 16; ++r) rli[r] = __builtin_amdgcn_rcpf(li_l[crow(r, hi)]); }
    else {
#pragma unroll
        for (int r = 0; r < 16; ++r) rli[r] = 1.f; }
    const bool prod = MLA && cur.split == 2;
    bf16_t* Ow = cur.O + (size_t)(wid * 32) * G::LDO;
    float* ossw = cur.oss + (size_t)(wid * 32) * 16;
#pragma unroll
    for (int r = 0; r < 16; ++r) {
#pragma unroll
        for (int d0 = 0; d0 < 4; ++d0) o[d0][r] *= rli[r];
        float sq = (o[0][r] * o[0][r] + o[1][r] * o[1][r]) + (o[2][r] * o[2][r] + o[3][r] * o[3][r]);
        sq += dpp_mov<0x128>(sq); sq += dpp_mov<0x124>(sq); sq += dpp_mov<0x122>(sq); sq += dpp_mov<0x121>(sq); sq = quarter_sum(sq);
        if (r32 == 0 && !prod) ((GAS float*)ossw)[(4 * hi + (r & 3) + 8 * (r >> 2)) * 16] = sq;
        asm volatile("" ::: "memory"); }
    if (prod) {
        GAS u32x4* pp = (GAS u32x4*)(cur.part + (size_t)(wid * 64 + lane) * 32);
#pragma unroll
        for (int q = 0; q < 8; ++q) { const int d0 = q >> 1, rb = (q & 1) * 8; u32x4 w;
            w.x = cvtpk(o[d0][rb], o[d0][rb + 1]); w.y = cvtpk(o[d0][rb + 2], o[d0][rb + 3]); w.z = cvtpk(o[d0][rb + 4], o[d0][rb + 5]); w.w = cvtpk(o[d0][rb + 6], o[d0][rb + 7]); pp[q] = w; }
        if (hi == 0) { f32x2 ml; ml[0] = m_reg; ml[1] = l_reg; *(GAS f32x2*)(cur.pml + (size_t)(wid * 32 + r32) * 2) = ml; }
        asm volatile("s_waitcnt vmcnt(0)" ::: "memory");
    } else {
#pragma unroll
        for (int r = 0; r < 16; ++r) { const int orow = crow(r, hi);
#pragma unroll
            for (int d0 = 0; d0 < 4; ++d0) { const float v = o[d0][r]; const float vn = lane_xor<1>(v);
                if ((r32 & 1) == 0) *(GAS unsigned*)(Ow + (size_t)orow * G::LDO + d0 * 32 + r32) = cvtpk(v, vn); } } }
    __syncthreads();
    if (prod && tid == 0) { __builtin_amdgcn_fence(__ATOMIC_RELEASE, "agent"); asm volatile("s_waitcnt vmcnt(0)" ::: "memory"); __hip_atomic_store(cur.flag, 1u, __ATOMIC_RELAXED, __HIP_MEMORY_SCOPE_AGENT); }
#undef SB_PUB
#undef SB_CHK
#undef RESC
#undef KBASE
#undef ACT
#undef MASKT
#undef PART
#undef FINISH
#undef HALF_STEP
}
}

__device__ const unsigned char ATT_DEAL[16][3] = {{2,31,255},{6,41,255},{27,49,51},{3,30,255},{47,62,255},{43,55,61},{42,59,63},{26,50,58},{5,56,60},{25,53,54},{7,48,255},{24,28,255},{1,44,52},{0,46,57},{4,45,255},{29,40,255}};
__device__ __forceinline__ void phase_attn(const Params& p, Ctx& X, int l) {
    LAS char* lds = (LAS char*)X.lds;
    const bf16_t* proj = (const bf16_t*)(p.ws + WS_PROJ); bf16_t* oatt = (bf16_t*)(p.ws + WS_OATT);
    { const bf16_t* qf = (const bf16_t*)(p.ws + WS_QRAW); const bf16_t* kf = (const bf16_t*)(p.ws + WS_KF); const bf16_t* kvraw = (const bf16_t*)(p.ws + WS_KVRAW);
      auto mk = [&](int L, int code) { const int bh = 2 * (L & 7) + ((L >> 3) & 1), kind = code >> 4, qb = code & 15, b = bh >> 3, h = bh & 7; att::Blk k;
          k.qg = p.q_head_g + l * QK; k.ct = (const float*)(p.ws + WS_ROPE);
          k.Q = qf + (size_t)(b * SEQ + qb * 256) * 1536 + h * QK; k.K = kf + (size_t)(b * SEQ) * 1536 + h * QK; k.V = kvraw + (size_t)(b * SEQ) * 2048 + h * 256 + 128;
          k.P0 = qb * 256; k.oss = (float*)(p.ws + WS_QF) + (size_t)(b * SEQ + qb * 256) * 16 + h;
          const int ntf = 4 * qb + 4; k.split = kind; k.nt = kind ? ntf / 2 : ntf; k.tb = kind == 2 ? ntf / 2 : 0; k.ldo = D;
          k.O = oatt + (size_t)(b * SEQ + qb * 256) * D + h * DV;
          const int item = bh * 8 + (qb & 7);
          k.part = (unsigned*)(p.ws + WS_OCAT) + (size_t)item * 16384; k.pml = (float*)(p.ws + WS_CKVN + MiB) + (size_t)item * 512; k.flag = (unsigned*)(p.ws + WS_CTL) + CW_FLG + (l * 128 + item) * 16;
          return k; };
      if (X.tid < QK) ((LAS float*)(lds + att::QG_LDS_OFF))[X.tid] = p.q_head_g[l * QK + X.tid];
      __syncthreads();
#ifndef MK_NO_MLA
#pragma unroll 1
      for (int pass = 0; pass < 3; ++pass)
      for (int L = X.blk; L < 256; L += X.G)
#pragma unroll 1
          for (int it = 0; it < 3; ++it) { const int code = ATT_DEAL[L >> 4][it]; if (code >= 48) continue;
              if ((code >> 4) != (pass == 0 ? 2 : pass == 1 ? 0 : 1)) continue;
              int tid_ = X.tid; asm volatile("" : "+v"(tid_));
              att::Seam<true> S; const att::Blk cur = mk(L, code); att::attn_prime<true>(cur, lds, S, tid_); att::attn_block<true>(cur, lds, S, tid_); }
#endif
    }
    __syncthreads();
    X.tid = X.wave * 64 + lane_id_volatile();
    { auto mk = [&](int L, int code) { const int bh = 2 * (L & 7) + ((L >> 3) & 1), qb = code & 15, b = bh >> 3, h = bh & 7; att::Blk k;
          k.Q = proj + (size_t)(b * SEQ + qb * 256) * INP + C_SQ + h * 128; k.K = proj + (size_t)(b * SEQ) * INP + C_SK + h * 128; k.V = proj + (size_t)(b * SEQ) * INP + C_SV + h * 128;
          k.O = oatt + (size_t)(b * SEQ + qb * 256) * D + 1024 + h * 128; k.P0 = qb * 256; k.qg = nullptr; k.ct = nullptr; k.oss = (float*)(p.ws + WS_QF) + (size_t)(b * SEQ + qb * 256) * 16 + 8 + h;
          k.tb = 0; k.nt = 0; k.split = 0; k.ldo = D; k.pml = nullptr; k.part = nullptr; k.flag = nullptr; return k; };
#ifndef MK_NO_SB
      for (int L = X.blk; L < 256; L += X.G)
#pragma unroll 1
          for (int it = 0; it < 3; ++it) { const int code = ATT_DEAL[L >> 4][it]; if (code < 48 || code == 255) continue;
              int tid_ = X.tid; asm volatile("" : "+v"(tid_));
              att::Seam<false> S; const att::Blk cur = mk(L, code); att::attn_prime<false>(cur, lds, S, tid_); att::attn_block<false>(cur, lds, S, tid_); }
#endif
    }
    __syncthreads();
}

__device__ __forceinline__ void cv_batch(const Params& p, Ctx& X, int b) {
    const int q = b + X.wave;
    if (q < (DEPTH - 1) * CV_NL) conv_item(p, p.ws, 1 + q / CV_NL, q % CV_NL, (LAS bf16_t*)(X.lds + 16384 + X.wave * 10240), X.lane);
}
__device__ __forceinline__ void cv_drain(const Params& p, Ctx& X, const bool t0, int limit) {
    unsigned* qc = (unsigned*)(p.ws + WS_CTL) + CW_CVQ; volatile LAS int* bq = (volatile LAS int*)(X.lds + 8192);
    for (;;) {
        if (t0) { int b = -1; if ((int)xb_ld(qc) < limit) { b = (int)xb_add(qc, 8u); if (b >= (DEPTH - 1) * CV_NL) b = -1; } bq[0] = b; }
        __syncthreads();
        const int b = bq[0];
        __syncthreads();
        if (b < 0) break;
        cv_batch(p, X, b);
    }
}
__device__ __forceinline__ void seam_convert(const Params& p, Ctx& X, const XcdBarrier& bar, const bool t0, int quota) {
    xcd_barrier(bar, t0, 1);
    unsigned* qc = (unsigned*)(p.ws + WS_CTL) + CW_CVQ; volatile LAS int* bq = (volatile LAS int*)(X.lds + 8192);
    for (;;) {
        if (t0) { int b = -1;
            if (quota > 0 && bar.st[3] == 0u && xb_ld(&bar.bar[XB_XGEN(bar.x)]) == bar.st[2] && (int)xb_ld(qc) < (DEPTH - 1) * CV_NL) { b = (int)xb_add(qc, 8u); if (b >= (DEPTH - 1) * CV_NL) b = -1; }
            bq[0] = b; }
        __syncthreads();
        const int b = bq[0];
        __syncthreads();
        if (b < 0) break;
        cv_batch(p, X, b); --quota;
    }
    xcd_barrier(bar, t0, 2);
}

constexpr int PH_PRO = 0, PH_MOD = 1, PH_L0 = 2, PH_PER_L = 9, PH_FINAL = PH_L0 + DEPTH * PH_PER_L, PH_COUNT = PH_FINAL + 1;

__global__ void __launch_bounds__(NTHR, 2) mk_fwd(Params p_) {
    extern __shared__ __attribute__((aligned(16))) unsigned char lds_raw[];
    const int wave0 = __builtin_amdgcn_readfirstlane((int)threadIdx.x >> 6);
#define MKTID() (wave0 * 64 + lane_id_volatile())
    Ctx X_; X_.lds = (LAS unsigned char*)lds_raw; X_.tid = MKTID(); X_.lane = X_.tid & 63; X_.wave = wave0;
    X_.G = gridDim.x; X_.blk = blockIdx.x; X_.gw = X_.blk * NWAVES + X_.wave; X_.ngw = X_.G * NWAVES;
#if MK_ONE_LAUNCH
    volatile LAS unsigned* bst = (volatile LAS unsigned*)(X_.lds + LDS_BYTES - 16);
    if (MKTID() == 0) { bst[0] = 0u; bst[1] = 0u; bst[2] = 0u; bst[3] = 0u; }
    __syncthreads();
    XcdBarrier bar = xcd_barrier_post((unsigned*)(p_.ws + WS_CTL) + CW_BAR, bst, MKTID() == 0);
#define SEAM() xcd_barrier(bar, MKTID() == 0)
#define SEAM_MODE(m) xcd_barrier(bar, MKTID() == 0, (m))
#define SEAMC(quota_) do { const int qq_ = (quota_); if (l < DEPTH - 1 && qq_ > 0) seam_convert(p, X, bar, MKTID() == 0, qq_); else SEAM(); } while (0)
#else
#define SEAM() do {} while (0)
#define SEAM_MODE(m) do {} while (0)
#define SEAMC(quota_) do {} while (0)
#endif
    const int lo = p_.ph_lo, hi = p_.ph_hi;
#ifdef MK_SKIP_MOE
#define DIAGT(ty) (((ty) < 10 || (ty) == 13) && (ty) != 14)
#elif defined(MK_DIAG_PH)
#define DIAGT(ty) ((ty) == MK_DIAG_PH)
#elif defined(MK_DIAG_MASK)
#define DIAGT(ty) (((MK_DIAG_MASK) >> (ty)) & 1)
#else
#define DIAGT(ty) true
#endif
#ifndef MK_DUP_MASK
#define MK_DUP_MASK 0
#endif
#define NREP(ty) ((((MK_DUP_MASK) >> (ty)) & 1) ? 2 : 1)
#define IN(k) (sgpr_launder(lo) <= (k) && (k) < sgpr_launder(hi))
#define BOTH(k) (IN(k) && IN((k) + 1))
#define FRESH0() do { X_.tid = MKTID(); asm volatile("" : "+v"(X_.tid)); X_.lane = X_.tid & 63; X_.wave = wave0; X_.gw = X_.blk * NWAVES + wave0; asm volatile("" : "+s"(X_.gw)); } while (0)
    if (DIAGT(0) && IN(PH_PRO)) for (int rep_ = 0; rep_ < NREP(0); ++rep_) { FRESH0(); phase_prologue(p_, X_); if (BOTH(PH_PRO)) SEAM(); }
    if (DIAGT(1) && IN(PH_MOD) && !(X_.ngw >= 4 * 48 * 8 && NWAVES == 8)) { FRESH0(); phase_modreduce(p_, X_); if (BOTH(PH_MOD)) SEAM(); }
#pragma unroll 1
    for (int li = 0; li < DEPTH; ++li) {
        int l = li; asm volatile("" : "+s"(l));
        const int P0 = PH_L0 + l * PH_PER_L;
        Params p = p_; Ctx X; X.lds = X_.lds; X.G = X_.G; X.blk = X_.blk; X.ngw = X_.ngw;
        asm volatile("" : "+s"(p.ws), "+s"(p.out));
        X.tid = MKTID(); asm volatile("" : "+v"(X.tid));
        X.lane = X.tid & 63; X.wave = wave0; X.gw = X.blk * NWAVES + X.wave;
        unsigned char* ws = p.ws; const float* mod = (const float*)(ws + WS_MOD);
#define FRESH() do { X.tid = MKTID(); asm volatile("" : "+v"(X.tid)); asm volatile("" : "+s"(p.ws), "+s"(p.out)); X.lane = X.tid & 63; X.wave = wave0; \
        X.gw = X.blk * NWAVES + X.wave; asm volatile("" : "+s"(X.gw)); ws = p.ws; mod = (const float*)(ws + WS_MOD); } while (0)
#ifdef MK_EXTRA_BAR
        for (int xb_ = 0; xb_ < sgpr_launder(MK_EXTRA_BAR); ++xb_) SEAM();
#endif
        if (DIAGT(2) && IN(P0 + 0)) for (int rep_ = 0; rep_ < NREP(2); ++rep_) { FRESH(); phase_norm1(p, X, l); if (BOTH(P0 + 0)) SEAMC(0);
#ifdef MK_PROBE_N1
            if (l > 0) { FRESH(); phase_norm1(p, X, l, true); SEAM(); }
#endif
        }
        if (DIAGT(3) && IN(P0 + 1)) for (int rep_ = 0; rep_ < NREP(3); ++rep_) { FRESH();
            GemmA g{(const bf16_t*)(ws + WS_H), D, D}; RegSched S; S.init(T, INP, D, (const bf16_t*)(ws + WS_WIN) + (size_t)l * INP * D, X.G, X.blk);
            EpiInProj E{(bf16_t*)(ws + WS_PROJ), (float*)(ws + WS_CQN)};
            gemm_run(X, g, S, E);
            if (BOTH(P0 + 1)) SEAMC(0); }
        if (DIAGT(5) && IN(P0 + 2)) for (int rep_ = 0; rep_ < NREP(5); ++rep_) { FRESH();
            { GemmA g{(const bf16_t*)(ws + WS_PROJ) + C_CQ, INP, QL}; RegSched S; S.init(T, 1536, QL, (const bf16_t*)(ws + WS_WUQ) + (size_t)l * 1536 * QL, X.G, X.blk);
              EpiScaleBf16 E{(bf16_t*)(ws + WS_QRAW), 1536, (const float*)(ws + WS_CQN), 0, 8, 1.f / QL}; gemm_run(X, g, S, E); }
            FRESH();
            { GemmA g{(const bf16_t*)(ws + WS_PROJ) + C_CKV, INP, KVL}; RegSched S; S.init(T, 2048, KVL, (const bf16_t*)(ws + WS_WUKV) + (size_t)l * 2048 * KVL, X.G, X.G - 1 - X.blk);
              EpiKV E{ws, p.k_head_g + l * QK}; gemm_run(X, g, S, E); }
            if (BOTH(P0 + 2)) SEAMC(X.blk >= 192 ? 3 : 0); }
        if (DIAGT(7) && IN(P0 + 3)) for (int rep_ = 0; rep_ < NREP(7); ++rep_) { FRESH();
#if MK_NAIVE_ATTN == 2
            { const bf16_t* kvraw = (const bf16_t*)(ws + WS_KVRAW); const bf16_t* proj = (const bf16_t*)(ws + WS_PROJ); bf16_t* oatt = (bf16_t*)(ws + WS_OATT);
              for (int i = X.blk * NTHR + X.tid; i < T * 1024; i += X.G * NTHR) { const int t = i >> 10, c = i & 1023, h = c >> 7, d = c & 127;
                  oatt[(size_t)t * D + c] = kvraw[(size_t)t * 2048 + h * 256 + 128 + d]; oatt[(size_t)t * D + 1024 + c] = proj[(size_t)t * INP + C_SV + c]; } }
#elif MK_NAIVE_ATTN == 1
            phase_attn_naive(p, X);
#else
            phase_attn(p, X, l);
#endif
            if (BOTH(P0 + 3)) SEAMC((int)((0x0000043112140001ull >> (4 * ((X.blk >> 4) & 15))) & 15ull)); }
        if (DIAGT(9) && IN(P0 + 4)) for (int rep_ = 0; rep_ < NREP(9); ++rep_) { FRESH();
            GemmA g{(const bf16_t*)(ws + WS_OATT), D, D}; RegSched S; S.init(T, D, D, (const bf16_t*)(ws + WS_WO) + (size_t)l * D * D, X.G, X.blk);
#ifdef MK_PROBE_O
            { EpiResid E0{p.out, p.out, mod + (size_t)l * 2 * 12288 + 2 * D, (bf16_t*)(ws + WS_XB), (const float*)(ws + WS_QF), (bf16_t*)(ws + WS_OCAT)}; gemm_run(X, g, S, E0); SEAM(); FRESH(); }
#endif
            EpiResid E{p.out, p.out, mod + (size_t)l * 2 * 12288 + 2 * D, (bf16_t*)(ws + WS_XB), (const float*)(ws + WS_QF), (bf16_t*)(ws + WS_XB)};
            gemm_run(X, g, S, E);
            if (BOTH(P0 + 4)) SEAMC(0); }
        if (DIAGT(10) && IN(P0 + 5)) for (int rep_ = 0; rep_ < NREP(10); ++rep_) { FRESH();
#ifdef MK_PROBE_N2R
            phase_norm2_route(p, X, l, true); SEAM(); FRESH();
#endif
            phase_norm2_route(p, X, l); if (BOTH(P0 + 5)) SEAMC(0); }
        if (DIAGT(11)) {
#pragma unroll 1
          for (int sub_ = 0; sub_ < 3; ++sub_) { int sb = sub_; asm volatile("" : "+s"(sb));
            if (IN(P0 + 6 + sb)) { FRESH();
              LAS int* cnt = (LAS int*)(X.lds + LDS_X); LAS int* rb = cnt + 16; load_counts(p, X, l, cnt, rb);
              int R = 0;
#pragma unroll 1
              for (int e = 0; e < NE; ++e) R += (cnt[e] + 255) >> 8;
              const int BIG = 1 << 30, rt1 = X.G / 4, nover = R * 4 > X.G ? R * 4 - X.G : 0;
              const bool flow = nover < X.G;
              const bool two = flow && X.blk < nover;
              unsigned* guf = (unsigned*)(ws + WS_CTL) + CW_GUF + l * 128 * 16;
              { GemmA g{(const bf16_t*)(ws + WS_H), D, D};
                MoeSched S{cnt, 4, X.G, X.blk, D, (const bf16_t*)(ws + WS_WGU) + (size_t)l * NE * 1024 * D, (size_t)1024 * D, (const int*)(ws + WS_TOK), sb == 0 ? 0 : X.G, sb == 0 ? X.G : (sb == 1 ? BIG : 0)};
                EpiGU E{(bf16_t*)(ws + WS_ACT)};
                gemm_run(X, g, S, E); }
              if (sb == 1 && flow) {
                  if (two) {
                      if (MKTID() == 0) { __builtin_amdgcn_fence(__ATOMIC_RELEASE, "agent"); asm volatile("s_waitcnt vmcnt(0)" ::: "memory");
                          for (int L = X.G + X.blk; L < R * 4; L += X.G) __hip_atomic_fetch_add(guf + (L >> 2) * 16, 1u, __ATOMIC_RELAXED, __HIP_MEMORY_SCOPE_AGENT); }
                      SEAM_MODE(2); } }
              const int c2 = X.G - 1 - X.blk;
              if (sb == 2 && flow) {
                  if (MKTID() == 0) { for (int L = rt1 * 8 + c2; L < R * 8; L += X.G) { int sp = 0;
                          while (__hip_atomic_load(guf + (L >> 3) * 16, __ATOMIC_RELAXED, __HIP_MEMORY_SCOPE_AGENT) < 4u && ++sp < 400000) __builtin_amdgcn_s_sleep(8); } }
                  if (wave0 == 0) { __builtin_amdgcn_fence(__ATOMIC_ACQUIRE, "agent"); asm volatile("s_waitcnt vmcnt(0)" ::: "memory"); }
                  __syncthreads(); }
              FRESH();
              { GemmA g{(const bf16_t*)(ws + WS_ACT), DE, DE};
                const bool part = sb == 1 && nover < X.G;
                MoeSched S{cnt, 8, part ? X.G - nover : X.G, part ? X.blk - nover : (sb == 2 && flow ? c2 : X.blk), DE, (const bf16_t*)(ws + WS_WDN) + (size_t)l * NE * D * DE, (size_t)D * DE, nullptr,
                           sb == 2 ? rt1 * 8 : 0, sb == 0 || (part && X.blk < nover) ? 0 : (sb == 1 ? rt1 * 8 : BIG)};
                EpiStoreBf16 E{(bf16_t*)(ws + WS_Y), D};
                gemm_run(X, g, S, E); }
              if (BOTH(P0 + 6 + sb)) {
                  if (sb == 2) { if (l < DEPTH - 1) cv_drain(p, X, MKTID() == 0, (l + 1) * CV_NL); SEAMC(0); }
                  else if (!flow) SEAM(); else if (sb == 0) SEAM_MODE(two ? 1 : 0); } } } }
    }
    if (DIAGT(13) && IN(PH_FINAL)) { FRESH0(); phase_norm1(p_, X_, DEPTH); }
#undef IN
#undef BOTH
#undef SEAM
#undef SEAM_MODE
#undef SEAMC
}

extern "C" void kernel_launch(void* const* d_in, const int* in_sizes, int n_in, void* d_out, int out_size, void* d_ws, size_t ws_size, hipStream_t stream) {
    static int grid = 0;
    if (grid == 0) {
        if (n_in != 21 || in_sizes[0] != T * D || out_size != T * D || ws_size < WS_END) {
            fprintf(stderr, "kernel_launch: unexpected shapes (n_in %d, in0 %d, out %d, ws %zu, need %zu); nothing launched\n", n_in, n_in > 0 ? in_sizes[0] : -1, out_size, ws_size, (size_t)WS_END); grid = -1; return; }
        int dev = 0, cus = 0, per_cu = 0;
        if (hipGetDevice(&dev) != hipSuccess || hipDeviceGetAttribute(&cus, hipDeviceAttributeMultiprocessorCount, dev) != hipSuccess) { grid = -1; return; }
        if (hipFuncSetAttribute((const void*)mk_fwd, hipFuncAttributeMaxDynamicSharedMemorySize, LDS_BYTES) != hipSuccess) { fprintf(stderr, "kernel_launch: hipFuncSetAttribute failed\n"); grid = -1; return; }
        if (hipOccupancyMaxActiveBlocksPerMultiprocessor(&per_cu, (const void*)mk_fwd, NTHR, LDS_BYTES) != hipSuccess || per_cu < 1)
            fprintf(stderr, "kernel_launch: occupancy query reports %d workgroups per CU\n", per_cu);
        (void)hipGetLastError();
        grid = cus;
    }
    if (grid < 0) return;
    (void)hipMemsetAsync((char*)d_ws + WS_CTL, 0, CTL_BYTES, stream);
#ifdef MK_PROBE_POISON
    (void)hipMemsetAsync((char*)d_ws + MK_PROBE_LO * MiB, 0xAA, (size_t)(MK_PROBE_HI - MK_PROBE_LO) * MiB, stream);
    (void)hipMemsetAsync(d_out, 0xAA, (size_t)T * D * 4, stream);
#endif
    Params p{};
    p.x = (const float*)d_in[0]; p.c = (const float*)d_in[1]; p.norm1_g = (const float*)d_in[2]; p.norm2_g = (const float*)d_in[3]; p.w_ada = (const float*)d_in[4]; p.b_ada = (const float*)d_in[5];
    p.w_in = (const float*)d_in[6]; p.q_lora_g = (const float*)d_in[7]; p.kv_lora_g = (const float*)d_in[8]; p.w_uq = (const float*)d_in[9]; p.w_ukv = (const float*)d_in[10];
    p.q_head_g = (const float*)d_in[11]; p.k_head_g = (const float*)d_in[12]; p.mla_out_g = (const float*)d_in[13]; p.sb_out_g = (const float*)d_in[14]; p.w_o = (const float*)d_in[15];
    p.router_w = (const float*)d_in[16]; p.router_b = (const float*)d_in[17]; p.w_gate = (const float*)d_in[18]; p.w_up = (const float*)d_in[19]; p.w_down = (const float*)d_in[20];
    p.out = (float*)d_out; p.ws = (unsigned char*)d_ws;
#if MK_ONE_LAUNCH
    p.ph_lo = 0; p.ph_hi = PH_COUNT;
    hipLaunchKernelGGL(mk_fwd, dim3(grid), dim3(NTHR), LDS_BYTES, stream, p);
#else
    for (int ph = 0; ph < PH_COUNT; ++ph) { p.ph_lo = ph; p.ph_hi = ph + 1; hipLaunchKernelGGL(mk_fwd, dim3(grid), dim3(NTHR), LDS_BYTES, stream, p); }
#endif
}
```

```cpp
#include <hip/hip_runtime.h>
#include <cstdio>
#include <cstdint>

#ifndef MK_ONE_LAUNCH
#define MK_ONE_LAUNCH 1
#endif
#ifndef MK_SIMPLE_GEMM
#define MK_SIMPLE_GEMM 0
#endif
#ifndef MK_NAIVE_ATTN
#define MK_NAIVE_ATTN 0
#endif

#ifndef MK_ATT_REP_MLA
#define MK_ATT_REP_MLA 1
#endif
#ifndef MK_ATT_REP_SB
#define MK_ATT_REP_SB 1
#endif
#define LAS __attribute__((address_space(3)))
#define GAS __attribute__((address_space(1)))
typedef unsigned short bf16_t;
typedef short bf16x8 __attribute__((ext_vector_type(8)));
typedef short s16x4 __attribute__((ext_vector_type(4)));
typedef float f32x4 __attribute__((ext_vector_type(4)));
typedef float f32x2 __attribute__((ext_vector_type(2)));
typedef float f32x16 __attribute__((ext_vector_type(16)));
typedef unsigned u32x4 __attribute__((ext_vector_type(4)));
typedef unsigned u32x2 __attribute__((ext_vector_type(2)));

constexpr int D = 2048, NB = 2, SEQ = 4096, T = NB * SEQ, DEPTH = 4;
constexpr int QL = 512, KVL = 256, ROPE = 64, NOPE = 128, QK = 192, DV = 128, NH = 8;
constexpr int INC = 3904, INP = 4096;
constexpr int NE = 16, DE = 512;
constexpr int C_CQ = 0, C_CKV = 512, C_KR = 768, C_SQ = 832, C_SK = 1856, C_SV = 2880;
constexpr int MAXROWS = 20480;
constexpr float EPS = 1e-6f;
constexpr float QSCALE_MLA = 0.10411754627697264f;
constexpr float QSCALE_SB = 0.12751743082459868f;
constexpr int NWAVES = 8, NTHR = 512;
constexpr int LDS_BYTES = 147456;
constexpr int LDS_X = 131072;

__device__ const float ROPE_INV[32] = {
1.000000000e+00f,7.498942018e-01f,5.623413324e-01f,4.216965139e-01f,3.162277639e-01f,2.371373922e-01f,1.778279394e-01f,1.333521456e-01f,1.000000015e-01f,7.498941571e-02f,5.623412877e-02f,4.216964915e-02f,3.162277862e-02f,2.371373586e-02f,1.778279431e-02f,1.333521493e-02f,9.999999776e-03f,7.498942316e-03f,5.623413250e-03f,4.216964822e-03f,3.162277862e-03f,2.371373819e-03f,1.778279431e-03f,1.333521446e-03f,1.000000047e-03f,7.498941850e-04f,5.623413017e-04f,4.216965463e-04f,3.162277862e-04f,2.371373848e-04f,1.778279402e-04f,1.333521504e-04f};

constexpr size_t MiB = 1u << 20;
constexpr size_t WS_CTL = 0, CTL_BYTES = 1 * MiB;
constexpr size_t WS_MODP = 1 * MiB;
constexpr size_t WS_MOD = 4 * MiB;
constexpr size_t WS_ROPE = 5 * MiB;
constexpr size_t WS_SLOT = 6 * MiB;
constexpr size_t WS_TOK = 7 * MiB;
constexpr size_t WS_WIN = 8 * MiB, WS_WUQ = 72 * MiB, WS_WUKV = 78 * MiB, WS_WO = 82 * MiB, WS_WGU = 114 * MiB, WS_WDN = 370 * MiB;
constexpr size_t WS_H = 498 * MiB, WS_PROJ = 530 * MiB, WS_CQN = 594 * MiB, WS_CKVN = 602 * MiB, WS_QRAW = 606 * MiB, WS_KVRAW = 630 * MiB;
constexpr size_t WS_QF = 662 * MiB, WS_KF = 686 * MiB, WS_OATT = 710 * MiB, WS_OCAT = 742 * MiB, WS_ACT = 774 * MiB, WS_Y = 794 * MiB, WS_XB = 874 * MiB, WS_END = 906 * MiB;
constexpr size_t WS_MOD2 = WS_MOD + 512 * 1024;
constexpr size_t WS_RWT = WS_CKVN;
constexpr int CW_BAR = 4096;
constexpr int CW_CVQ = 61440;
constexpr int CW_GUF = 49152;
constexpr int CW_FLG = 32768;
constexpr int CW_CNT = 16384;

__device__ __forceinline__ float bf2f(unsigned b) { return __uint_as_float(b << 16); }
__device__ __forceinline__ float bflo(unsigned w) { return __uint_as_float(w << 16); }
__device__ __forceinline__ float bfhi(unsigned w) { return __uint_as_float(w & 0xffff0000u); }
__device__ __forceinline__ unsigned cvtpk(float lo, float hi) { unsigned r; asm volatile("v_cvt_pk_bf16_f32 %0, %1, %2" : "=v"(r) : "v"(lo), "v"(hi)); return r; }
__device__ __forceinline__ bf16_t f2bf(float f) { return (bf16_t)(cvtpk(f, 0.f) & 0xffffu); }
template <int M> __device__ __forceinline__ float lane_xor(float v) { return __int_as_float(__builtin_amdgcn_ds_swizzle(__float_as_int(v), (M << 10) | 0x1f)); }
__device__ __forceinline__ float half_sum(float v) { auto rr = __builtin_amdgcn_permlane32_swap(__float_as_uint(v), __float_as_uint(v), false, false); return __uint_as_float(rr[0]) + __uint_as_float(rr[1]); }
__device__ __forceinline__ float half_max(float v) { auto rr = __builtin_amdgcn_permlane32_swap(__float_as_uint(v), __float_as_uint(v), false, false); return fmaxf(__uint_as_float(rr[0]), __uint_as_float(rr[1])); }
template <int CTRL> __device__ __forceinline__ float dpp_mov(float v) { return __int_as_float(__builtin_amdgcn_update_dpp(0, __float_as_int(v), CTRL, 0xf, 0xf, true)); }
__device__ __forceinline__ float quarter_sum(float v) { auto rr = __builtin_amdgcn_permlane16_swap(__float_as_uint(v), __float_as_uint(v), false, false); return __uint_as_float(rr[0]) + __uint_as_float(rr[1]); }
__device__ __forceinline__ float wave_sum_dpp(float v) {
    v += dpp_mov<0x128>(v); v += dpp_mov<0x124>(v); v += dpp_mov<0x122>(v); v += dpp_mov<0x121>(v);
    return half_sum(quarter_sum(v));
}
__device__ __forceinline__ float wave_sum(float v) { return wave_sum_dpp(v); }
__device__ __forceinline__ float wave_max(float v) {
    v = fmaxf(v, lane_xor<1>(v)); v = fmaxf(v, lane_xor<2>(v)); v = fmaxf(v, lane_xor<4>(v)); v = fmaxf(v, lane_xor<8>(v)); v = fmaxf(v, lane_xor<16>(v));
    return half_max(v);
}

__device__ __forceinline__ int lane_id_volatile() { int l; asm volatile("v_mbcnt_lo_u32_b32 %0, -1, 0\n\tv_mbcnt_hi_u32_b32 %0, -1, %0" : "=v"(l)); return l; }
__device__ __forceinline__ int sgpr_launder(int v) { asm volatile("" : "+s"(v)); return v; }
#define XB_TMO      128
#define XB_XCNT(j)  (256  + 64 * (j))
#define XB_XSUB(j)  (1280 + 64 * (j))
#define XB_XGEN(j)  (2304 + 64 * (j))
#define XB_TOP      3328
#define XB_TOPGEN   3392
#define XCD_BAR_WORDS 3456
#define XB_SPIN_CAP (1u << 18)
__device__ __forceinline__ unsigned xb_ld(unsigned* p)              { return __hip_atomic_load(p, __ATOMIC_RELAXED, __HIP_MEMORY_SCOPE_AGENT); }
__device__ __forceinline__ unsigned xb_add(unsigned* p, unsigned v) { return __hip_atomic_fetch_add(p, v, __ATOMIC_RELAXED, __HIP_MEMORY_SCOPE_AGENT); }
__device__ __forceinline__ unsigned xb_xcc_id() { return (unsigned)__builtin_amdgcn_s_getreg((3 << 11) | 20) & 0xFu; }
#define XB_SPIN(cond, bar) do { unsigned _sp = 0; while (cond) { __builtin_amdgcn_s_sleep(1); \
    if ((++_sp & 255u) == 0u) { if (xb_ld(&(bar)[XB_TMO])) break; if (_sp > XB_SPIN_CAP) { atomicAdd(&(bar)[XB_TMO], 1u); break; } } } } while (0)
struct XcdBarrier { unsigned* bar; unsigned x; volatile LAS unsigned* st; };
__device__ __forceinline__ XcdBarrier xcd_barrier_post(unsigned* bar, volatile LAS unsigned* st, const bool t0) {
    XcdBarrier b; b.bar = bar; b.x = xb_xcc_id(); b.st = st;
    if (t0) (void)xb_add(&bar[XB_XCNT(b.x)], 1u);
    return b;
}
__device__ __forceinline__ void xcd_barrier_complete(unsigned* bar, unsigned x, unsigned& nloc, unsigned& nx) {
    const unsigned G = gridDim.x * gridDim.y * gridDim.z;
    unsigned sum, cnt, mine, sp = 0u;
    for (;;) {
        sum = 0u; cnt = 0u; mine = 0u;
#pragma unroll
        for (unsigned j = 0; j < 16; ++j) { const unsigned c = xb_ld(&bar[XB_XCNT(j)]); sum += c; cnt += (c > 0u) ? 1u : 0u; mine = (j == x) ? c : mine; }
        if (sum == G) break;
        __builtin_amdgcn_s_sleep(1);
        if ((++sp & 255u) == 0u) { if (xb_ld(&bar[XB_TMO])) break; if (sp > XB_SPIN_CAP) { atomicAdd(&bar[XB_TMO], 1u); break; } }
    }
    nloc = mine > 0u ? mine : 1u; nx = cnt > 0u ? cnt : 1u;
}
__device__ __forceinline__ void xcd_barrier(const XcdBarrier& b, const bool t0, const int mode = 0) {
    if (mode == 2) {
        if (t0) { unsigned* bar = b.bar; const unsigned gen = b.st[2];
            XB_SPIN(xb_ld(&bar[XB_XGEN(b.x)]) == gen, bar);
            __builtin_amdgcn_fence(__ATOMIC_ACQUIRE, "agent");
            asm volatile("s_waitcnt vmcnt(0)" ::: "memory"); }
        __syncthreads();
        return; }
    asm volatile("s_waitcnt vmcnt(0)" ::: "memory");
    __syncthreads();
    if (t0) {
        unsigned* bar = b.bar;
        __builtin_amdgcn_s_waitcnt(0);
        unsigned nloc = b.st[0], nx = b.st[1];
        if (nloc == 0u) { xcd_barrier_complete(bar, b.x, nloc, nx); b.st[0] = nloc; b.st[1] = nx; }
        const unsigned old = xb_add(&bar[XB_XSUB(b.x)], 1u);
        const unsigned gen = old / nloc;
        if (old + 1u == (gen + 1u) * nloc) {
            __builtin_amdgcn_fence(__ATOMIC_RELEASE, "agent");
            asm volatile("s_waitcnt vmcnt(0)" ::: "memory");
            const unsigned og = xb_add(&bar[XB_TOP], 1u);
            const unsigned tg = og / nx;
            if (og + 1u != (tg + 1u) * nx) XB_SPIN(xb_ld(&bar[XB_TOP]) < (tg + 1u) * nx, bar);
            xb_add(&bar[XB_XGEN(b.x)], 1u);
            __builtin_amdgcn_fence(__ATOMIC_ACQUIRE, "agent");
            asm volatile("s_waitcnt vmcnt(0)" ::: "memory");
        } else if (mode == 1) { b.st[2] = gen; b.st[3] = 0u;
        } else {
            asm volatile("buffer_inv sc1" ::: "memory");
            XB_SPIN(xb_ld(&bar[XB_XGEN(b.x)]) == gen, bar);
            asm volatile("s_waitcnt vmcnt(0)" ::: "memory");
        }
        if (mode == 1 && old + 1u == (gen + 1u) * nloc) { b.st[2] = gen; b.st[3] = 1u; }
    }
    __syncthreads();
}

struct Params {
    const float *x, *c, *norm1_g, *norm2_g, *w_ada, *b_ada, *w_in, *q_lora_g, *kv_lora_g, *w_uq, *w_ukv, *q_head_g, *k_head_g, *mla_out_g, *sb_out_g, *w_o,
                *router_w, *router_b, *w_gate, *w_up, *w_down;
    float* out; unsigned char* ws;
    int ph_lo, ph_hi;
};
struct Ctx {
    LAS unsigned char* lds;
    int tid, lane, wave, G, blk, gw, ngw;
};

struct GUnit {
    int arow0;
    const int* amap;
    int avalid;
    const bf16_t* Bt;
    int orow0, ocol0;
    int aux;
};
struct GemmA { const bf16_t* A; int lda; int K; };

struct RegSched {
    static constexpr bool GATHER = false;
    int nM, nN, nwg, G, c, K; const bf16_t* Bt;
    __device__ void init(int M, int N, int K_, const bf16_t* Bt_, int G_, int c_) { nM = M / 256; nN = N / 256; nwg = nM * nN; G = G_; c = c_; K = K_; Bt = Bt_; }
    __device__ __forceinline__ bool next(int i, GUnit& u) const {
        const long L = (long)i * G + c; if (L >= nwg) return false;
        int wgid = (int)L; { const int q = nwg / 8, r = nwg % 8, xcd = wgid % 8, off = wgid / 8; wgid = (xcd < r ? xcd * (q + 1) : r * (q + 1) + (xcd - r) * q) + off; }
        const int nig = 8 * nN, gid = wgid / nig, fm = gid * 8, gsz = (nM - fm) < 8 ? (nM - fm) : 8;
        const int pm = fm + ((wgid % nig) % gsz), pn = (wgid % nig) / gsz;
        u.arow0 = pm * 256; u.amap = nullptr; u.avalid = 256; u.Bt = Bt + (size_t)pn * 256 * K; u.orow0 = pm * 256; u.ocol0 = pn * 256; u.aux = 0;
        return true;
    }
};
struct MoeSched {
    static constexpr bool GATHER = true;
    const LAS int* cnt;
    int npn, G, c, K; const bf16_t* W; size_t wstride; const int* tok;
    int lo, hi;
    __device__ __forceinline__ bool next(int i, GUnit& u) const {
        const int L = lo + i * G + c; if (L < lo || L >= hi) return false;
        const int tile = L / npn, pn = L - tile * npn;
        int tb = 0, rb = 0, e = -1, rt = 0, ce = 0;
#pragma unroll 1
        for (int k = 0; k < NE; ++k) { const int ck = cnt[k], nt = (ck + 255) >> 8; if (e < 0 && tile < tb + nt) { e = k; rt = tile - tb; ce = ck; } if (e < 0) { tb += nt; rb += nt * 256; } }
        if (e < 0) return false;
        u.arow0 = rb + rt * 256; u.amap = tok ? tok + e * T + rt * 256 : nullptr; u.avalid = (ce - rt * 256) < 256 ? (ce - rt * 256) : 256;
        u.Bt = W + (size_t)e * wstride + (size_t)pn * 256 * K; u.orow0 = rb + rt * 256; u.ocol0 = pn * 256; u.aux = e;
        return true;
    }
};

struct EpiStoreBf16 {
    static constexpr bool PERM = true, ROWSS = false, RESC = false, TABPRE = false, RESID = false, KVK = false;
    bf16_t* O; int ldc;
    __device__ __forceinline__ float rowpre(const GUnit&, int) const { return 1.f; }
    __device__ __forceinline__ void rowss(const GUnit&, int, int, float) const {}
    __device__ __forceinline__ void store8(const GUnit& u, int r, int c, f32x4 v0, f32x4 v1) const {
        u32x4 w; w.x = cvtpk(v0[0], v0[1]); w.y = cvtpk(v0[2], v0[3]); w.z = cvtpk(v1[0], v1[1]); w.w = cvtpk(v1[2], v1[3]);
        *(GAS u32x4*)(O + (size_t)(u.orow0 + r) * ldc + u.ocol0 + c) = w;
    }
};
struct EpiInProj {
    static constexpr bool PERM = true, ROWSS = true, RESC = false, TABPRE = false, RESID = false, KVK = false;
    bf16_t* O; float* SS;
    __device__ __forceinline__ float rowpre(const GUnit&, int) const { return 1.f; }
    __device__ __forceinline__ void store8(const GUnit& u, int r, int c, f32x4 v0, f32x4 v1) const {
        u32x4 w; w.x = cvtpk(v0[0], v0[1]); w.y = cvtpk(v0[2], v0[3]); w.z = cvtpk(v1[0], v1[1]); w.w = cvtpk(v1[2], v1[3]);
        *(GAS u32x4*)(O + (size_t)(u.orow0 + r) * INP + u.ocol0 + c) = w;
    }
    __device__ __forceinline__ void rowss(const GUnit& u, int r, int wc, float ss) const { if (u.ocol0 < 768) SS[(size_t)(u.orow0 + r) * 12 + (u.ocol0 >> 8) * 4 + wc] = ss; }
};
struct EpiScaleBf16 {
    static constexpr bool PERM = true, ROWSS = false, RESC = false, TABPRE = true, RESID = false, KVK = false;
    bf16_t* O; int ldc; const float* SS; int p0, np; float invn;
    __device__ __forceinline__ float rowpre(const GUnit& u, int r) const { const GAS float* q = (const GAS float*)(SS + (size_t)(u.orow0 + r) * 12 + p0); float s = 0.f; for (int i = 0; i < np; ++i) s += q[i]; return rsqrtf(s * invn + EPS); }
    __device__ __forceinline__ void rowss(const GUnit&, int, int, float) const {}
    __device__ __forceinline__ void rs_table(const GUnit& u, int tid, LAS float* tab) const {
        if (tid < 256) { const GAS float* q = (const GAS float*)(SS + (size_t)(u.orow0 + tid) * 12 + p0); float sm = 0.f; for (int i = 0; i < np; ++i) sm += q[i]; tab[tid] = rsqrtf(sm * invn + EPS); } }
    __device__ __forceinline__ void store8(const GUnit& u, int r, int c, f32x4 v0, f32x4 v1) const {
        u32x4 w; w.x = cvtpk(v0[0], v0[1]); w.y = cvtpk(v0[2], v0[3]); w.z = cvtpk(v1[0], v1[1]); w.w = cvtpk(v1[2], v1[3]);
        *(GAS u32x4*)(O + (size_t)(u.orow0 + r) * ldc + u.ocol0 + c) = w;
    }
};
struct EpiKV {
    static constexpr bool PERM = true, ROWSS = false, RESC = false, TABPRE = true, RESID = false, KVK = true;
    unsigned char* ws; const float* kg;
    __device__ __forceinline__ float rowpre(const GUnit&, int) const { return 1.f; }
    __device__ __forceinline__ void rowss(const GUnit&, int, int, float) const {}
    __device__ __forceinline__ void rs_table(const GUnit& u, int tid, LAS float* tab) const {
        if (tid < 256) { const GAS float* q = (const GAS float*)((const float*)(ws + WS_CQN) + (size_t)(u.orow0 + tid) * 12 + 8); tab[tid] = rsqrtf(((q[0] + q[1]) + (q[2] + q[3])) * (1.f / KVL) + EPS); } }
};
struct EpiResid {
    static constexpr bool PERM = true, ROWSS = false, TABPRE = false, KVK = false;
    __device__ __forceinline__ float rowpre(const GUnit&, int) const { return 1.f; }
    __device__ __forceinline__ void rowss(const GUnit&, int, int, float) const {}
    const float* xin; float* xout; const float* gate; bf16_t* xb; const float* oss; bf16_t* xbo;
    static constexpr bool RESID = true, RESC = true;
    __device__ __forceinline__ void rs_table(const GUnit& u, int tid, LAS float* tab) const {
        if (tid < 256) { const GAS f32x4* q = (const GAS f32x4*)(oss + (size_t)(u.orow0 + tid) * 16); const f32x4 a = q[0], b = q[1], c = q[2], d = q[3];
            const float rm = rsqrtf((((a[0] + a[1]) + (a[2] + a[3])) + ((b[0] + b[1]) + (b[2] + b[3]))) * (1.f / 1024) + EPS), rsb = rsqrtf((((c[0] + c[1]) + (c[2] + c[3])) + ((d[0] + d[1]) + (d[2] + d[3]))) * (1.f / 1024) + EPS);
            tab[tid] = rm * __builtin_amdgcn_rcpf(rsb); tab[256 + tid] = rsb; }
    }
    __device__ __forceinline__ void rstds8(const GUnit& u, int wr, int fr, int fq, float (&rm)[2][4], float (&rsb)[2][4]) const {
        f32x4 q[2][4];
#pragma unroll
        for (int ai = 0; ai < 2; ++ai)
#pragma unroll
            for (int m = 0; m < 4; ++m) q[ai][m] = *(const GAS f32x4*)(oss + (size_t)(u.orow0 + ai * 128 + wr * 64 + m * 16 + fr) * 16 + 4 * fq);
#pragma unroll
        for (int ai = 0; ai < 2; ++ai)
#pragma unroll
            for (int m = 0; m < 4; ++m) { float sv = (q[ai][m][0] + q[ai][m][1]) + (q[ai][m][2] + q[ai][m][3]); sv += lane_xor<16>(sv);
                auto rr = __builtin_amdgcn_permlane32_swap(__float_as_uint(sv), __float_as_uint(sv), false, false);
                rm[ai][m] = rsqrtf(__uint_as_float(rr[0]) * (1.f / 1024) + EPS); rsb[ai][m] = rsqrtf(__uint_as_float(rr[1]) * (1.f / 1024) + EPS); }
    }
    __device__ __forceinline__ f32x4 gate4(const GUnit& u, int c) const { return *(const GAS f32x4*)(gate + (size_t)(u.orow0 >> 12) * 12288 + u.ocol0 + c); }
    __device__ __forceinline__ f32x4 load4(const GUnit& u, int r, int c) const { const u32x2 w = *(const GAS u32x2*)(xb + (size_t)(u.orow0 + r) * D + u.ocol0 + c); return (f32x4){bflo(w.x), bfhi(w.x), bflo(w.y), bfhi(w.y)}; }
    __device__ __forceinline__ u32x4 load8(const GUnit& u, int r, int c) const { return *(const GAS u32x4*)(xb + (size_t)(u.orow0 + r) * D + u.ocol0 + c); }
    __device__ __forceinline__ void put8(const GUnit& u, int r, int c, u32x4 w) const { *(GAS u32x4*)(xbo + (size_t)(u.orow0 + r) * D + u.ocol0 + c) = w; }
    __device__ __forceinline__ void put4(const GUnit& u, int r, int c, f32x4 v) const { u32x2 w; w.x = cvtpk(v[0], v[1]); w.y = cvtpk(v[2], v[3]); *(GAS u32x2*)(xb + (size_t)(u.orow0 + r) * D + u.ocol0 + c) = w; }
    __device__ __forceinline__ void store4(const GUnit& u, int r, int c, f32x4 v) const {
        const int row = u.orow0 + r, col = u.ocol0 + c, b = row >> 12;
        const f32x4 g = *(const GAS f32x4*)(gate + (size_t)b * 12288 + col);
        const f32x4 xi = *(const GAS f32x4*)(xin + (size_t)row * D + col);
        *(GAS f32x4*)(xout + (size_t)row * D + col) = xi + g * v;
    }
};
struct EpiGU {
    static constexpr bool PERM = true, ROWSS = false, RESC = false, TABPRE = false, RESID = false, KVK = false;
    __device__ __forceinline__ float rowpre(const GUnit&, int) const { return 1.f; }
    __device__ __forceinline__ void rowss(const GUnit&, int, int, float) const {}
    bf16_t* act;
    __device__ __forceinline__ float su(float g, float up) const { return g * __builtin_amdgcn_rcpf(1.f + __builtin_amdgcn_exp2f(-1.4426950408889634f * g)) * up; }
    __device__ __forceinline__ void store8(const GUnit& u, int r, int c, f32x4 v0, f32x4 v1) const {
        u32x2 w; w.x = cvtpk(su(v0[0], v0[1]), su(v0[2], v0[3])); w.y = cvtpk(su(v1[0], v1[1]), su(v1[2], v1[3]));
        *(GAS u32x2*)(act + (size_t)(u.orow0 + r) * DE + ((u.ocol0 + c) >> 1)) = w;
    }
};

template <class Epi, class Sched>
__device__ __forceinline__ void gemm_simple(const GemmA g, const Sched& S, const Epi& E, const int tid) {
    const int wid = tid >> 6, lane = tid & 63, fr = lane & 15, fq = lane >> 4;
    GUnit u;
    for (int i = 0; S.next(i, u); ++i) {
        size_t aoff[2];
#pragma unroll
        for (int mi = 0; mi < 2; ++mi) { const int tr = 32 * wid + 16 * mi + fr; const int grow = u.amap ? (tr < u.avalid ? u.amap[tr] : 0) : u.arow0 + tr; aoff[mi] = (size_t)grow * g.lda + 8 * fq; }
        for (int cb = 0; cb < 8; ++cb) {
            f32x4 acc[2][2];
#pragma unroll
            for (int a = 0; a < 2; ++a)
#pragma unroll
                for (int b = 0; b < 2; ++b) acc[a][b] = (f32x4){0.f, 0.f, 0.f, 0.f};
            size_t boff[2];
#pragma unroll
            for (int n = 0; n < 2; ++n) { const int col = Epi::PERM ? 32 * cb + 8 * (fr >> 2) + 4 * n + (fr & 3) : 32 * cb + 16 * n + fr; boff[n] = (size_t)col * g.K + 8 * fq; }
            for (int k0 = 0; k0 < g.K; k0 += 32) {
                bf16x8 a[2], b[2];
#pragma unroll
                for (int mi = 0; mi < 2; ++mi) a[mi] = *(const GAS bf16x8*)(g.A + aoff[mi] + k0);
#pragma unroll
                for (int n = 0; n < 2; ++n) b[n] = *(const GAS bf16x8*)(u.Bt + boff[n] + k0);
#pragma unroll
                for (int mi = 0; mi < 2; ++mi)
#pragma unroll
                    for (int n = 0; n < 2; ++n) acc[mi][n] = __builtin_amdgcn_mfma_f32_16x16x32_bf16(b[n], a[mi], acc[mi][n], 0, 0, 0);
            }
#pragma unroll
            for (int mi = 0; mi < 2; ++mi) { const int r = 32 * wid + 16 * mi + fr;
                if constexpr (Epi::PERM) E.store8(u, r, 32 * cb + 8 * fq, acc[mi][0], acc[mi][1]);
                else {
#pragma unroll
                    for (int n = 0; n < 2; ++n) E.store4(u, r, 32 * cb + 16 * n + 4 * fq, acc[mi][n]); } }
        }
    }
}

namespace pg8 {
constexpr int BM = 256, BK = 64, HALF = 128, HTB = HALF * BK * 2, STAGE_BYTES = 8 * HTB;
__device__ __forceinline__ int lds_byte(int r, int c) { const int st = (r >> 4) * 2 + (c >> 5), rr = r & 15, cc = c & 31, ob = rr * 64 + cc * 2; return st * 1024 + (ob ^ (((ob >> 9) & 1) << 5)); }
__device__ __forceinline__ void stage_rc(int b, int& R, int& C) { const int st = b / 1024, sb = b % 1024, swz = sb ^ (((sb >> 9) & 1) << 5); R = (st >> 1) * 16 + swz / 64; C = (st & 1) * 32 + (swz % 64) / 2; }
__device__ __forceinline__ int perm32(int rho) { const int n = rho >> 4, i = rho & 15; return 8 * (i >> 2) + 4 * n + (i & 3); }

template <class Epi>
__device__ __forceinline__ void run_epi(const Epi& E, const f32x4 (&acc)[2][2][4][2], const GUnit& u, int wr, int wc, int fr, int fq, const LAS float* tab) {
#pragma unroll
    for (int ai = 0; ai < 2; ++ai)
#pragma unroll
        for (int m = 0; m < 4; ++m) { const int r = ai * HALF + wr * 64 + m * 16 + fr;
            float pre; if constexpr (Epi::TABPRE) pre = tab[r]; else pre = E.rowpre(u, r);
            float ss = 0.f;
#pragma unroll
            for (int bj = 0; bj < 2; ++bj) {
                if constexpr (Epi::PERM) { const f32x4 v0 = acc[ai][bj][m][0] * pre, v1 = acc[ai][bj][m][1] * pre;
                    E.store8(u, r, bj * HALF + wc * 32 + 8 * fq, v0, v1);
                    if constexpr (Epi::ROWSS) ss += ((v0[0] * v0[0] + v0[1] * v0[1]) + (v0[2] * v0[2] + v0[3] * v0[3])) + ((v1[0] * v1[0] + v1[1] * v1[1]) + (v1[2] * v1[2] + v1[3] * v1[3])); }
                else {
#pragma unroll
                    for (int n = 0; n < 2; ++n) E.store4(u, r, bj * HALF + wc * 32 + 16 * n + 4 * fq, acc[ai][bj][m][n]); } }
            if constexpr (Epi::ROWSS) { ss = half_sum(quarter_sum(ss)); if (fq == 0) E.rowss(u, r, wc, ss); } }
}
template <class Epi>
__device__ __forceinline__ void run_epi_resid(const Epi& E, const f32x4 (&acc)[2][2][4][2], const GUnit& u, int wr, int wc, int fr, int fq, const LAS float* tab) {
    f32x4 gt[2][2]; float rsb8[2][4];
#pragma unroll
    for (int a = 0; a < 2; ++a)
#pragma unroll
        for (int m = 0; m < 4; ++m) rsb8[a][m] = tab[256 + a * HALF + wr * 64 + m * 16 + fr];
#pragma unroll
    for (int bj = 0; bj < 2; ++bj)
#pragma unroll
        for (int n = 0; n < 2; ++n) gt[bj][n] = E.gate4(u, bj * HALF + wc * 32 + 8 * fq + 4 * n);
#pragma unroll
    for (int ai = 0; ai < 2; ++ai) {
        u32x4 xi[4][2];
#pragma unroll
        for (int m = 0; m < 4; ++m)
#pragma unroll
            for (int bj = 0; bj < 2; ++bj) xi[m][bj] = E.load8(u, ai * HALF + wr * 64 + m * 16 + fr, bj * HALF + wc * 32 + 8 * fq);
#pragma unroll
        for (int m = 0; m < 4; ++m)
#pragma unroll
            for (int bj = 0; bj < 2; ++bj) { const u32x4 w = xi[m][bj]; const float rs = rsb8[ai][m];
                const f32x4 a0 = acc[ai][bj][m][0] * rs, a1 = acc[ai][bj][m][1] * rs, g0 = gt[bj][0], g1 = gt[bj][1];
                u32x4 o;
                o.x = cvtpk(bflo(w.x) + g0[0] * a0[0], bfhi(w.x) + g0[1] * a0[1]); o.y = cvtpk(bflo(w.y) + g0[2] * a0[2], bfhi(w.y) + g0[3] * a0[3]);
                o.z = cvtpk(bflo(w.z) + g1[0] * a1[0], bfhi(w.z) + g1[1] * a1[1]); o.w = cvtpk(bflo(w.w) + g1[2] * a1[2], bfhi(w.w) + g1[3] * a1[3]);
                E.put8(u, ai * HALF + wr * 64 + m * 16 + fr, bj * HALF + wc * 32 + 8 * fq, o); }
        asm volatile("" ::: "memory");
    }
}

template <class Epi>
__device__ __forceinline__ void run_epi_kv(const Epi& E, const f32x4 (&acc)[2][2][4][2], const GUnit& u, int wr, int wc, int fr, int fq, const LAS float* tab, LAS unsigned char* lds, int tid) {
    { const int ln_ = lane_id_volatile(); fr = ln_ & 15; fq = ln_ >> 4; tid = (wr * 4 + wc) * 64 + ln_; }
    LAS float* part = (LAS float*)(lds + LDS_X + 256 + 4096); LAS float* krs = part + 1024;
    const int h = u.ocol0 >> 8;
#pragma unroll
    for (int ai = 0; ai < 2; ++ai)
#pragma unroll
        for (int m = 0; m < 4; ++m) { const int r = ai * HALF + wr * 64 + m * 16 + fr; const float pre = tab[r];
            { const f32x4 v0 = acc[ai][1][m][0] * pre, v1 = acc[ai][1][m][1] * pre;
              u32x4 w; w.x = cvtpk(v0[0], v0[1]); w.y = cvtpk(v0[2], v0[3]); w.z = cvtpk(v1[0], v1[1]); w.w = cvtpk(v1[2], v1[3]);
              *(GAS u32x4*)((bf16_t*)(E.ws + WS_KVRAW) + (size_t)(u.orow0 + r) * 2048 + u.ocol0 + HALF + wc * 32 + 8 * fq) = w; }
            { const f32x4 v0 = acc[ai][0][m][0] * pre, v1 = acc[ai][0][m][1] * pre;
              float ss = ((v0[0] * v0[0] + v0[1] * v0[1]) + (v0[2] * v0[2] + v0[3] * v0[3])) + ((v1[0] * v1[0] + v1[1] * v1[1]) + (v1[2] * v1[2] + v1[3] * v1[3]));
              ss = half_sum(quarter_sum(ss)); if (fq == 0) part[wc * 256 + r] = ss; } }
    const int hf = __builtin_amdgcn_readfirstlane(tid >> 8), row = tid & 255, j0 = hf * 16, t = u.orow0 + row, pos = t & (SEQ - 1);
    float o1[16], o2[16];
    { const bf16_t* kr = (const bf16_t*)(E.ws + WS_PROJ) + (size_t)t * INP + C_KR + j0;
      const u32x4 a0 = *(const GAS u32x4*)kr, a1 = *(const GAS u32x4*)(kr + 8), b0 = *(const GAS u32x4*)(kr + 32), b1 = *(const GAS u32x4*)(kr + 40);
      const float* cp = (const float*)(E.ws + WS_ROPE) + (size_t)pos * 32 + j0; const float* sp = cp + SEQ * 32; const float* g1 = E.kg + 128 + j0; const float* g2 = g1 + 32;
      const unsigned aw[8] = {a0.x, a0.y, a0.z, a0.w, a1.x, a1.y, a1.z, a1.w}, bw[8] = {b0.x, b0.y, b0.z, b0.w, b1.x, b1.y, b1.z, b1.w};
      float sq = 0.f;
#pragma unroll
      for (int q = 0; q < 4; ++q) { const f32x4 c = *(const GAS f32x4*)(cp + 4 * q), sn = *(const GAS f32x4*)(sp + 4 * q), ga = *(const GAS f32x4*)(g1 + 4 * q), gb = *(const GAS f32x4*)(g2 + 4 * q);
#pragma unroll
          for (int i = 0; i < 4; ++i) { const int j = 4 * q + i; const float ka = (j & 1) ? bfhi(aw[j >> 1]) : bflo(aw[j >> 1]), kb = (j & 1) ? bfhi(bw[j >> 1]) : bflo(bw[j >> 1]);
              sq += ka * ka + kb * kb; const float x1 = ka * ga[i], x2 = kb * gb[i];
              o1[j] = x1 * c[i] - x2 * sn[i]; o2[j] = x1 * sn[i] + x2 * c[i]; } }
      krs[hf * 256 + row] = sq; }
    asm volatile("s_waitcnt lgkmcnt(0)" ::: "memory");
    __builtin_amdgcn_s_barrier();
    { const f32x4 gn0 = *(const GAS f32x4*)(E.kg + wc * 32 + 8 * fq), gn1 = *(const GAS f32x4*)(E.kg + wc * 32 + 8 * fq + 4);
#pragma unroll
      for (int ai = 0; ai < 2; ++ai)
#pragma unroll
        for (int m = 0; m < 4; ++m) { const int r = ai * HALF + wr * 64 + m * 16 + fr;
            const float rk = rsqrtf((((part[r] + part[256 + r]) + (part[512 + r] + part[768 + r])) + (krs[r] + krs[256 + r])) * (1.f / QK) + EPS), sc = tab[r] * rk;
            const f32x4 v0 = acc[ai][0][m][0] * sc * gn0, v1 = acc[ai][0][m][1] * sc * gn1;
            u32x4 w; w.x = cvtpk(v0[0], v0[1]); w.y = cvtpk(v0[2], v0[3]); w.z = cvtpk(v1[0], v1[1]); w.w = cvtpk(v1[2], v1[3]);
            *(GAS u32x4*)((bf16_t*)(E.ws + WS_KF) + (size_t)(u.orow0 + r) * 1536 + h * QK + wc * 32 + 8 * fq) = w; } }
    { const float rk = rsqrtf((((part[row] + part[256 + row]) + (part[512 + row] + part[768 + row])) + (krs[row] + krs[256 + row])) * (1.f / QK) + EPS);
      bf16_t* dst = (bf16_t*)(E.ws + WS_KF) + (size_t)t * 1536 + h * QK + 128 + j0;
      u32x4 w;
      w.x = cvtpk(o1[0] * rk, o1[1] * rk); w.y = cvtpk(o1[2] * rk, o1[3] * rk); w.z = cvtpk(o1[4] * rk, o1[5] * rk); w.w = cvtpk(o1[6] * rk, o1[7] * rk); *(GAS u32x4*)dst = w;
      w.x = cvtpk(o1[8] * rk, o1[9] * rk); w.y = cvtpk(o1[10] * rk, o1[11] * rk); w.z = cvtpk(o1[12] * rk, o1[13] * rk); w.w = cvtpk(o1[14] * rk, o1[15] * rk); *(GAS u32x4*)(dst + 8) = w;
      w.x = cvtpk(o2[0] * rk, o2[1] * rk); w.y = cvtpk(o2[2] * rk, o2[3] * rk); w.z = cvtpk(o2[4] * rk, o2[5] * rk); w.w = cvtpk(o2[6] * rk, o2[7] * rk); *(GAS u32x4*)(dst + 32) = w;
      w.x = cvtpk(o2[8] * rk, o2[9] * rk); w.y = cvtpk(o2[10] * rk, o2[11] * rk); w.z = cvtpk(o2[12] * rk, o2[13] * rk); w.w = cvtpk(o2[14] * rk, o2[15] * rk); *(GAS u32x4*)(dst + 40) = w; }
    asm volatile("s_waitcnt lgkmcnt(0)" ::: "memory");
}

template <class Epi, class Sched>
__device__ __forceinline__ void gemm_phase(LAS unsigned char* lds, const GemmA g, const Sched& S, const Epi& E, const int tid) {
    const int wid = __builtin_amdgcn_readfirstlane(tid >> 6), lane = tid & 63, wr = wid >> 2, wc = wid & 3, fr = lane & 15, fq = lane >> 4;
    const int K = g.K, nt = K / BK, lda = g.lda;
    unsigned voffB[2];
#pragma unroll
    for (int i = 0; i < 2; ++i) { int R, C; stage_rc(tid * 16 + i * 8192, R, C); const int Rb = Epi::PERM ? ((R & ~31) + perm32(R & 31)) : R; voffB[i] = (unsigned)(Rb * K + C) * 2u; }
    unsigned voffA[2][2];
#define PG8_SETA(u_) do { const int _t16 = (wid * 64 + lane_id_volatile()) * 16;                   \
        _Pragma("unroll") for (int _h = 0; _h < (Sched::GATHER ? 2 : 1); ++_h) _Pragma("unroll") for (int _i = 0; _i < 2; ++_i) { int _R, _C; stage_rc(_t16 + _i * 8192, _R, _C); const int _tr = _h * HALF + _R; \
        const int _gr = (u_).amap ? (_tr < (u_).avalid ? (u_).amap[_tr] : 0) : (u_).arow0 + _tr; voffA[_h][_i] = (unsigned)(_gr * lda + _C) * 2u; } } while (0)
    const size_t kstep = (size_t)(BK * 2);
    const size_t hstepB = (size_t)HALF * K * 2, hstepA = (size_t)HALF * lda * 2;
    const unsigned ldsw = (unsigned)wid * 1024u;
    const int aoff = lds_byte(wr * 64 + fr, fq * 8), boff = lds_byte(wc * 32 + fr, fq * 8);
#define PG8_SA(b, h) (((b) * 2 + (h)) * HTB)
#define PG8_SB(b, h) ((4 + (b) * 2 + (h)) * HTB)
#define PG8_STAGE(bufoff, gbase, voff) do { _Pragma("unroll") for (int _i = 0; _i < 2; ++_i) \
        __builtin_amdgcn_global_load_lds((const unsigned*)((const char*)(gbase) + (voff)[_i]), (LAS unsigned*)(lds + (bufoff) + ldsw + _i * 8192), 16, 0, 0); } while (0)
#define PG8_STAGE_A1(bufoff, gbase) do { if constexpr (Sched::GATHER) PG8_STAGE(bufoff, gbase, voffA[1]); else PG8_STAGE(bufoff, (gbase) + hstepA, voffA[0]); } while (0)
#define PG8_LDA(dst, b, h) do { _Pragma("unroll") for (int m = 0; m < 4; ++m) _Pragma("unroll") for (int k = 0; k < 2; ++k) dst[m][k] = *(const LAS bf16x8*)(lds + PG8_SA(b, h) + aoff + m * 2048 + k * 1024); } while (0)
#define PG8_LDB(dst, b, h) do { _Pragma("unroll") for (int n = 0; n < 2; ++n) _Pragma("unroll") for (int k = 0; k < 2; ++k) dst[n][k] = *(const LAS bf16x8*)(lds + PG8_SB(b, h) + boff + n * 2048 + k * 1024); } while (0)
#define PG8_MMA(ai, bj, At, Bt) do { __builtin_amdgcn_s_setprio(1); _Pragma("unroll") for (int m = 0; m < 4; ++m) _Pragma("unroll") for (int n = 0; n < 2; ++n) _Pragma("unroll") for (int k = 0; k < 2; ++k) \
        acc[ai][bj][m][n] = __builtin_amdgcn_mfma_f32_16x16x32_bf16(Bt[n][k], At[m][k], acc[ai][bj][m][n], 0, 0, 0); __builtin_amdgcn_s_setprio(0); } while (0)
#define PG8_WAIT_V(n) asm volatile("s_waitcnt vmcnt(" #n ")" ::: "memory")
#define PG8_WAIT_L(n) asm volatile("s_waitcnt lgkmcnt(" #n ")" ::: "memory")
#define PG8_BAR __builtin_amdgcn_s_barrier()
#define PG8_SCHED __builtin_amdgcn_sched_barrier(0)
    GUnit cur, nxt; int ui = 0;
    if (!S.next(0, cur)) return;
    f32x4 acc[2][2][4][2];
#pragma unroll
    for (int a = 0; a < 2; ++a)
#pragma unroll
        for (int b = 0; b < 2; ++b)
#pragma unroll
            for (int m = 0; m < 4; ++m)
#pragma unroll
                for (int n = 0; n < 2; ++n) acc[a][b][m][n] = (f32x4){0.f, 0.f, 0.f, 0.f};
    bf16x8 At[4][2], B0[2][2], B1[2][2];
    LAS float* rtab = (LAS float*)(lds + LDS_X + 256);
    if constexpr (Epi::RESC || Epi::TABPRE) E.rs_table(cur, tid, rtab);
    const char* cA = (const char*)g.A; const char* cB = (const char*)cur.Bt;
    PG8_SETA(cur);
    asm volatile("s_waitcnt vmcnt(0)" ::: "memory");
    PG8_STAGE(PG8_SB(0, 0), cB, voffB); PG8_STAGE(PG8_SB(0, 1), cB + hstepB, voffB); PG8_STAGE(PG8_SA(0, 0), cA, voffA[0]); PG8_STAGE_A1(PG8_SA(0, 1), cA);
    if (wr == 1) PG8_BAR;
    PG8_WAIT_V(2); PG8_BAR;
    PG8_STAGE(PG8_SB(1, 0), cB + kstep, voffB); PG8_STAGE(PG8_SA(1, 0), cA + kstep, voffA[0]); PG8_STAGE(PG8_SB(1, 1), cB + hstepB + kstep, voffB);
    PG8_WAIT_V(6); PG8_BAR;
    for (;;) {
        const bool has_next = S.next(ui + 1, nxt);
        const char* nB = has_next ? (const char*)nxt.Bt : cB;

        for (int t = 0; t < nt; t += 2) {
            const bool last = (t == nt - 2);
            const char* a1 = cA + (size_t)(t + 1) * kstep;
            const char* a2 = last ? cA : cA + (size_t)(t + 2) * kstep; const char* b2 = last ? nB : cB + (size_t)(t + 2) * kstep;
            const char* a3 = a2 + kstep; const char* b3 = b2 + kstep;
            if constexpr (Epi::RESC) {
                if (t == nt / 2) {
#pragma unroll
                    for (int ai = 0; ai < 2; ++ai)
#pragma unroll
                        for (int m = 0; m < 4; ++m) { const float ratio = rtab[(ui & 1) * 512 + ai * HALF + wr * 64 + m * 16 + fr];
#pragma unroll
                            for (int bj = 0; bj < 2; ++bj)
#pragma unroll
                                for (int n = 0; n < 2; ++n) acc[ai][bj][m][n] *= ratio; } } }
            PG8_LDB(B0, 0, 0); PG8_LDB(B1, 0, 1); PG8_SCHED; PG8_LDA(At, 0, 0); PG8_STAGE_A1(PG8_SA(1, 1), a1);
            if (last && has_next) { PG8_SETA(nxt); if constexpr (Epi::RESC || Epi::TABPRE) E.rs_table(nxt, wid * 64 + lane_id_volatile(), rtab + ((ui + 1) & 1) * 512); }
            PG8_WAIT_V(8); PG8_WAIT_L(0); PG8_BAR; PG8_MMA(0, 0, At, B0); PG8_MMA(0, 1, At, B1); PG8_BAR; PG8_SCHED;
            PG8_LDA(At, 0, 1); PG8_STAGE(PG8_SB(0, 0), b2, voffB); PG8_STAGE(PG8_SB(0, 1), b2 + hstepB, voffB); PG8_STAGE(PG8_SA(0, 0), a2, voffA[0]);
            PG8_WAIT_V(8); PG8_WAIT_L(0); PG8_BAR; PG8_MMA(1, 0, At, B0); PG8_MMA(1, 1, At, B1); PG8_BAR; PG8_SCHED;
            PG8_LDB(B0, 1, 0); PG8_LDB(B1, 1, 1); PG8_SCHED; PG8_LDA(At, 1, 0); PG8_STAGE_A1(PG8_SA(0, 1), a2);
            PG8_WAIT_V(8); PG8_WAIT_L(0); PG8_BAR; PG8_MMA(0, 0, At, B0); PG8_MMA(0, 1, At, B1); PG8_BAR; PG8_SCHED;
            PG8_LDA(At, 1, 1); PG8_STAGE(PG8_SB(1, 0), b3, voffB); PG8_STAGE(PG8_SB(1, 1), b3 + hstepB, voffB); PG8_STAGE(PG8_SA(1, 0), a3, voffA[0]);
            PG8_WAIT_V(8); PG8_WAIT_L(0); PG8_BAR; PG8_MMA(1, 0, At, B0); PG8_MMA(1, 1, At, B1); PG8_BAR; PG8_SCHED;
        }
        if (wr == 0) PG8_BAR;
        if constexpr (Epi::KVK) run_epi_kv(E, acc, cur, wr, wc, fr, fq, rtab + (ui & 1) * 512, lds, 0); else if constexpr (!Epi::RESID) run_epi(E, acc, cur, wr, wc, fr, fq, rtab + (ui & 1) * 512); else run_epi_resid(E, acc, cur, wr, wc, fr, fq, rtab + (ui & 1) * 512);
        if (!has_next) break;
#pragma unroll
        for (int a = 0; a < 2; ++a)
#pragma unroll
            for (int b = 0; b < 2; ++b)
#pragma unroll
                for (int m = 0; m < 4; ++m)
#pragma unroll
                    for (int n = 0; n < 2; ++n) acc[a][b][m][n] = (f32x4){0.f, 0.f, 0.f, 0.f};
        cur = nxt; cB = nB; ++ui;
        if (wr == 1) PG8_BAR;
    }
    PG8_WAIT_V(0);
    PG8_BAR;
#undef PG8_SETA
#undef PG8_SA
#undef PG8_SB
#undef PG8_STAGE
#undef PG8_STAGE_A1
#undef PG8_LDA
#undef PG8_LDB
#undef PG8_MMA
#undef PG8_WAIT_V
#undef PG8_WAIT_L
#undef PG8_BAR
#undef PG8_SCHED
}
}

template <class Epi, class Sched>
__device__ __forceinline__ void gemm_run(Ctx& X, const GemmA g, const Sched& S, const Epi& E) {
#if MK_SIMPLE_GEMM
    gemm_simple(g, S, E, X.tid);
#else
    pg8::gemm_phase(X.lds, g, S, E, X.tid);
#endif
}

__device__ __forceinline__ void conv_tile(const float* W, int ldw, int K, bf16_t* WT, int k0, int n0, int dmul, int dadd, float sc, LAS bf16_t* scr, int lane, const float* ksc = nullptr) {
    constexpr int PITCH = 72;
    f32x4 v[16];
    const int nq = (lane & 15) * 4, kq = lane >> 4;
#pragma unroll
    for (int i = 0; i < 16; ++i) v[i] = __builtin_nontemporal_load((const GAS f32x4*)(W + (size_t)(k0 + 4 * i + kq) * ldw + n0 + nq));
#pragma unroll
    for (int i = 0; i < 16; ++i) { const int k = 4 * i + kq; const float sk = ksc ? sc * ksc[k0 + k] : sc;
#pragma unroll
        for (int j = 0; j < 4; ++j) scr[(nq + j) * PITCH + k] = f2bf(v[i][j] * sk); }
    asm volatile("s_waitcnt lgkmcnt(0)" ::: "memory");
    const int c = lane & 7;
#pragma unroll
    for (int j = 0; j < 8; ++j) { const int n = (lane >> 3) + 8 * j;
        const u32x4 o = *(const LAS u32x4*)(scr + n * PITCH + 8 * c);
        __builtin_nontemporal_store(o, (GAS u32x4*)(WT + (size_t)((n0 + n) * dmul + dadd) * K + k0 + 8 * c)); }
    asm volatile("s_waitcnt lgkmcnt(0)" ::: "memory");
}

constexpr int CV_PER_L = 1952 + 192 + 128 + 1024, CV_PER_LE = 768, CV_NL = CV_PER_L + 16 * CV_PER_LE;
__device__ __forceinline__ void conv_item(const Params& p, unsigned char* ws, int L, int r, LAS bf16_t* scr, int lane) {
    const float* W; bf16_t* WT; const float* ksc = nullptr; int ldw, K, k0, n0, dmul = 1, dadd = 0; float sc = 1.f;
    if (r < CV_PER_L) {
        if (r < 1952) { const int kt = r / 61, nt = r % 61; n0 = nt * 64; k0 = kt * 64; sc = (n0 >= C_SQ && n0 < C_SK) ? QSCALE_SB : 1.f;
            W = p.w_in + (size_t)L * D * INC; ldw = INC; K = D; WT = (bf16_t*)(ws + WS_WIN) + (size_t)L * INP * D; }
        else if (r < 1952 + 192) { const int q = r - 1952, kt = q / 24, nt = q % 24; k0 = kt * 64; n0 = nt * 64;
            W = p.w_uq + (size_t)L * QL * 1536; ldw = 1536; K = QL; WT = (bf16_t*)(ws + WS_WUQ) + (size_t)L * 1536 * QL; ksc = p.q_lora_g + L * QL; }
        else if (r < 1952 + 192 + 128) { const int q = r - 1952 - 192, kt = q / 32, nt = q % 32; k0 = kt * 64; n0 = nt * 64;
            W = p.w_ukv + (size_t)L * KVL * 2048; ldw = 2048; K = KVL; WT = (bf16_t*)(ws + WS_WUKV) + (size_t)L * 2048 * KVL; ksc = p.kv_lora_g + L * KVL; }
        else { const int q = r - 1952 - 192 - 128, kt = q / 32, nt = q % 32; k0 = kt * 64; n0 = nt * 64;
            W = p.w_o + (size_t)L * D * D; ldw = D; K = D; WT = (bf16_t*)(ws + WS_WO) + (size_t)L * D * D; ksc = kt < 16 ? p.mla_out_g + L * 1024 : p.sb_out_g + L * 1024 - 1024; }
    } else { const int q0 = r - CV_PER_L, le = L * 16 + q0 / CV_PER_LE, q = q0 % CV_PER_LE;
        if (q < 512) { const int qq = q & 255, kt = qq / 8, nt = qq % 8; k0 = kt * 64; n0 = nt * 64; dmul = 2; dadd = q >> 8;
            W = (q < 256 ? p.w_gate : p.w_up) + (size_t)le * D * DE; ldw = DE; K = D; WT = (bf16_t*)(ws + WS_WGU) + (size_t)le * 1024 * D; }
        else { const int qq = q - 512, kt = qq / 32, nt = qq % 32; k0 = kt * 64; n0 = nt * 64;
            W = p.w_down + (size_t)le * DE * D; ldw = D; K = DE; WT = (bf16_t*)(ws + WS_WDN) + (size_t)le * D * DE; }
    }
    conv_tile(W, ldw, K, WT, k0, n0, dmul, dadd, sc, scr, lane, ksc);
}

__device__ __forceinline__ void phase_prologue(const Params& p, Ctx& X) {
    unsigned char* ws = p.ws;
    LAS float* cact = (LAS float*)X.lds;
    for (int i = X.tid; i < NB * D; i += NTHR) { const float c = p.c[i]; cact[i] = c / (1.f + expf(-c)); }
    __syncthreads();
    { float* ct = (float*)(ws + WS_ROPE); float* st = ct + SEQ * 32;
      for (int i = X.blk * NTHR + X.tid; i < SEQ * 32; i += X.G * NTHR) { const int pos = i >> 5, j = i & 31;
          const float ang = (float)pos * ROPE_INV[j]; const double rev = (double)ang * 0.15915494309189535; const float fr = (float)(rev - floor(rev));
          ct[i] = __builtin_amdgcn_cosf(fr); st[i] = __builtin_amdgcn_sinf(fr); } }
    { float* rwt = (float*)(ws + WS_RWT);
      for (int i = X.blk * NTHR + X.tid; i < D * NE; i += X.G * NTHR) rwt[(size_t)(i & 15) * D + (i >> 4)] = p.router_w[i]; }
    { float* modp = (float*)(ws + WS_MODP);
      for (int it = X.gw; it < 4 * 48 * 8; it += X.ngw) { const int kc = it & 7, cg = (it >> 3) % 48, l = it / (8 * 48);
          const float* w = p.w_ada + ((size_t)l * D + kc * 256) * 12288 + cg * 256 + 4 * X.lane;
          f32x4 a0 = {0.f, 0.f, 0.f, 0.f}, a1 = {0.f, 0.f, 0.f, 0.f};
#pragma unroll 8
          for (int k = 0; k < 256; ++k) { const f32x4 wv = __builtin_nontemporal_load((const GAS f32x4*)(w + (size_t)k * 12288)); const float s0 = cact[kc * 256 + k], s1 = cact[D + kc * 256 + k]; a0 += s0 * wv; a1 += s1 * wv; }
          float* o = modp + (((size_t)kc * 4 + l) * 2) * 12288 + cg * 256 + 4 * X.lane;
          *(GAS f32x4*)o = a0; *(GAS f32x4*)(o + 12288) = a1; } }
    __syncthreads();
    LAS bf16_t* scr = (LAS bf16_t*)(X.lds + 16384 + X.wave * 10240);
    for (int r = X.gw; r < CV_NL; r += X.ngw) conv_item(p, ws, 0, r, scr, X.lane);
    { const u32x4 z = {0u, 0u, 0u, 0u};
      for (int i = X.blk * NTHR + X.tid; i < 4 * 192 * (D / 8); i += X.G * NTHR) { const int l = i / (192 * (D / 8)), r = i % (192 * (D / 8));
          *(GAS u32x4*)((bf16_t*)(ws + WS_WIN) + ((size_t)l * INP + INC) * D + (size_t)r * 8) = z; } }
}

__device__ __forceinline__ void phase_modreduce(const Params& p, Ctx& X) {
    const float* modp = (const float*)(p.ws + WS_MODP); float* mod = (float*)(p.ws + WS_MOD);
    for (int i = X.blk * NTHR + X.tid; i < 4 * 2 * 12288; i += X.G * NTHR) { const int j = i % 12288, l = i / (2 * 12288);
        float s = p.b_ada[l * 12288 + j];
#pragma unroll
        for (int kc = 0; kc < 8; ++kc) s += modp[(size_t)kc * (4 * 2 * 12288) + i];
        mod[i] = s;
        if (j >= 4 * D && j < 5 * D) ((float*)(p.ws + WS_MOD2))[i / 12288 * D + (j - 4 * D)] = p.norm2_g[l * D + (j - 4 * D)] * (1.f + s);
        if (j >= D && j < 2 * D) ((float*)(p.ws + WS_MOD2 + 65536))[i / 12288 * D + (j - D)] = p.norm1_g[l * D + (j - D)] * (1.f + s); }
}

__device__ __forceinline__ void load_counts(const Params& p, Ctx& X, int l, LAS int* cnt, LAS int* rb) {
    if (X.tid < NE) { const unsigned* c = (const unsigned*)(p.ws + WS_CTL) + CW_CNT + (l * 16 + X.tid) * 64;
        const int ce = (int)__hip_atomic_load(c, __ATOMIC_RELAXED, __HIP_MEMORY_SCOPE_AGENT);
        LAS int* tmp = rb + 16; cnt[X.tid] = ce; tmp[X.tid] = ((ce + 255) >> 8) << 8;
        asm volatile("s_waitcnt lgkmcnt(0)" ::: "memory");
        int acc = 0;
#pragma unroll
        for (int k = 0; k < NE; ++k) { const int v = tmp[k]; if (k < X.tid) acc += v; }
        rb[X.tid] = acc; }
    __syncthreads();
}
__device__ __forceinline__ void load_row_combine(const Params& p, Ctx& X, int t, int l, const LAS int* rb, f32x4 (&v)[8]) {
    const int b = t >> 12;
    const float* xr = (l == 0 ? p.x : p.out) + (size_t)t * D + 4 * X.lane;
#pragma unroll
    for (int j = 0; j < 8; ++j) v[j] = *(const GAS f32x4*)(xr + 256 * j);
#if !defined(MK_SKIP_MOE) && !defined(MK_NO_COMBINE)
    if (l > 0) {
        const int* sl = (const int*)(p.ws + WS_SLOT) + (size_t)t * 8;
        const int e0 = sl[0], p0 = sl[1], e1 = sl[2], p1 = sl[3]; const float w0 = __int_as_float(sl[4]), w1 = __int_as_float(sl[5]);
        const bf16_t* y0 = (const bf16_t*)(p.ws + WS_Y) + (size_t)(rb[e0] + p0) * D + 4 * X.lane;
        const bf16_t* y1 = (const bf16_t*)(p.ws + WS_Y) + (size_t)(rb[e1] + p1) * D + 4 * X.lane;
        const float* gf = (const float*)(p.ws + WS_MOD) + ((size_t)(l - 1) * 2 + b) * 12288 + 5 * D + 4 * X.lane;
#pragma unroll
        for (int j = 0; j < 8; ++j) { const u32x2 a = *(const GAS u32x2*)(y0 + 256 * j), c = *(const GAS u32x2*)(y1 + 256 * j); const f32x4 g = *(const GAS f32x4*)(gf + 256 * j);
            v[j][0] += g[0] * (w0 * bflo(a.x) + w1 * bflo(c.x)); v[j][1] += g[1] * (w0 * bfhi(a.x) + w1 * bfhi(c.x));
            v[j][2] += g[2] * (w0 * bflo(a.y) + w1 * bflo(c.y)); v[j][3] += g[3] * (w0 * bfhi(a.y) + w1 * bfhi(c.y)); }
    }
#endif
}
__device__ __forceinline__ void norm_mod(Ctx& X, f32x4 (&v)[8], const float* g, const float* shift, const float* scale) {
    float ss = 0.f;
#pragma unroll
    for (int j = 0; j < 8; ++j) ss += (v[j][0] * v[j][0] + v[j][1] * v[j][1]) + (v[j][2] * v[j][2] + v[j][3] * v[j][3]);
    const float rstd = rsqrtf(wave_sum(ss) * (1.f / D) + EPS);
#pragma unroll
    for (int j = 0; j < 8; ++j) { const f32x4 gg = *(const GAS f32x4*)(g + 4 * X.lane + 256 * j), sh = *(const GAS f32x4*)(shift + 4 * X.lane + 256 * j), sc = *(const GAS f32x4*)(scale + 4 * X.lane + 256 * j);
        v[j] = v[j] * rstd * gg * (1.f + sc) + sh; }
}
__device__ __forceinline__ void norm_mod2(Ctx& X, f32x4 (&v)[8], const float* a, const float* shift) {
    f32x4 aa[8], sh[8];
#pragma unroll
    for (int j = 0; j < 8; ++j) { aa[j] = *(const GAS f32x4*)(a + 4 * X.lane + 256 * j); sh[j] = *(const GAS f32x4*)(shift + 4 * X.lane + 256 * j); }
    asm volatile("" ::: "memory");
    float ss = 0.f;
#pragma unroll
    for (int j = 0; j < 8; ++j) ss += (v[j][0] * v[j][0] + v[j][1] * v[j][1]) + (v[j][2] * v[j][2] + v[j][3] * v[j][3]);
    const float rstd = rsqrtf(wave_sum(ss) * (1.f / D) + EPS);
#pragma unroll
    for (int j = 0; j < 8; ++j) v[j] = v[j] * rstd * aa[j] + sh[j];
}
__device__ __forceinline__ void store_row_bf16(Ctx& X, bf16_t* dst, const f32x4 (&v)[8]) {
#pragma unroll
    for (int j = 0; j < 8; ++j) { u32x2 w; w.x = cvtpk(v[j][0], v[j][1]); w.y = cvtpk(v[j][2], v[j][3]); *(GAS u32x2*)(dst + 4 * X.lane + 256 * j) = w; }
}

__device__ __forceinline__ void phase_norm1(const Params& p, Ctx& X, int l, const bool dm = false) {
    LAS int* cnt = (LAS int*)(X.lds + LDS_X); LAS int* rb = cnt + 16;
    if (l > 0) load_counts(p, X, l - 1, cnt, rb);
    const float* mod = (const float*)(p.ws + WS_MOD);
    bf16_t* xb = (bf16_t*)(p.ws + WS_XB);
    for (int t0 = X.gw; t0 < T; t0 += 2 * X.ngw) {
        const int t1 = t0 + X.ngw; const bool two = t1 < T; const int tt[2] = {t0, two ? t1 : t0};
        f32x4 v[2][8];
        if (l == 0) {
#pragma unroll
            for (int r = 0; r < 2; ++r) { const float* xr = p.x + (size_t)tt[r] * D + 4 * X.lane;
#pragma unroll
                for (int j = 0; j < 8; ++j) v[r][j] = __builtin_nontemporal_load((const GAS f32x4*)(xr + 256 * j)); }
        } else {
#pragma unroll
            for (int r = 0; r < 2; ++r) { const bf16_t* xr = xb + (size_t)tt[r] * D + 4 * X.lane;
#pragma unroll
                for (int j = 0; j < 8; ++j) { const u32x2 w = *(const GAS u32x2*)(xr + 256 * j); v[r][j] = (f32x4){bflo(w.x), bfhi(w.x), bflo(w.y), bfhi(w.y)}; } }
        }
        if (l > 0) {
            u32x2 ya[2][8], yc[2][8]; float w0[2], w1[2];
#pragma unroll
            for (int r = 0; r < 2; ++r) { const int* sl = (const int*)(p.ws + WS_SLOT) + (size_t)tt[r] * 8;
                const int e0 = sl[0], p0 = sl[1], e1 = sl[2], p1 = sl[3]; w0[r] = __int_as_float(sl[4]); w1[r] = __int_as_float(sl[5]);
                const bf16_t* y0 = (const bf16_t*)(p.ws + WS_Y) + (size_t)(rb[e0] + p0) * D + 4 * X.lane;
                const bf16_t* y1 = (const bf16_t*)(p.ws + WS_Y) + (size_t)(rb[e1] + p1) * D + 4 * X.lane;
#pragma unroll
                for (int j = 0; j < 8; ++j) { ya[r][j] = __builtin_nontemporal_load((const GAS u32x2*)(y0 + 256 * j)); yc[r][j] = __builtin_nontemporal_load((const GAS u32x2*)(y1 + 256 * j)); } }
#pragma unroll
            for (int r = 0; r < 2; ++r) { const int b = tt[r] >> 12;
                const float* gf = mod + ((size_t)(l - 1) * 2 + b) * 12288 + 5 * D + 4 * X.lane;
                f32x4 gq[8];
#pragma unroll
                for (int j = 0; j < 8; ++j) gq[j] = *(const GAS f32x4*)(gf + 256 * j);
                asm volatile("" ::: "memory");
#pragma unroll
                for (int j = 0; j < 8; ++j) { const f32x4 g = gq[j]; const u32x2 a = ya[r][j], c = yc[r][j];
                    v[r][j][0] += g[0] * (w0[r] * bflo(a.x) + w1[r] * bflo(c.x)); v[r][j][1] += g[1] * (w0[r] * bfhi(a.x) + w1[r] * bfhi(c.x));
                    v[r][j][2] += g[2] * (w0[r] * bflo(a.y) + w1[r] * bflo(c.y)); v[r][j][3] += g[3] * (w0[r] * bfhi(a.y) + w1[r] * bfhi(c.y)); } }
        }
#pragma unroll
        for (int r = 0; r < 2; ++r) { if (r == 1 && !two) break;
            if (l == DEPTH) { float* xo = p.out + (size_t)tt[r] * D + 4 * X.lane;
#pragma unroll
                for (int j = 0; j < 8; ++j) __builtin_nontemporal_store(v[r][j], (GAS f32x4*)(xo + 256 * j)); }
            else store_row_bf16(X, (dm ? (bf16_t*)(p.ws + WS_OCAT) : xb) + (size_t)tt[r] * D, v[r]);
            if (l < DEPTH) { const int b = tt[r] >> 12; const float* m = mod + ((size_t)l * 2 + b) * 12288;
                norm_mod2(X, v[r], (const float*)(p.ws + WS_MOD2 + 65536) + ((size_t)l * 2 + b) * D, m + 0 * D);
                store_row_bf16(X, (bf16_t*)(p.ws + (dm ? WS_OATT : WS_H)) + (size_t)tt[r] * D, v[r]); } }
    }
}
__device__ __forceinline__ void phase_prep1(const Params& p, Ctx& X, int l) {
    const bf16_t* proj = (const bf16_t*)(p.ws + WS_PROJ);
    for (int t = X.gw; t < T; t += X.ngw) {
        const u32x4 a = *(const GAS u32x4*)(proj + (size_t)t * INP + C_CQ + 8 * X.lane);
        float f[8] = {bflo(a.x), bfhi(a.x), bflo(a.y), bfhi(a.y), bflo(a.z), bfhi(a.z), bflo(a.w), bfhi(a.w)};
        float ss = 0.f;
#pragma unroll
        for (int i = 0; i < 8; ++i) ss += f[i] * f[i];
        float rstd = rsqrtf(wave_sum(ss) * (1.f / QL) + EPS);
        const float* g = p.q_lora_g + l * QL + 8 * X.lane;
        u32x4 o; o.x = cvtpk(f[0] * rstd * g[0], f[1] * rstd * g[1]); o.y = cvtpk(f[2] * rstd * g[2], f[3] * rstd * g[3]); o.z = cvtpk(f[4] * rstd * g[4], f[5] * rstd * g[5]); o.w = cvtpk(f[6] * rstd * g[6], f[7] * rstd * g[7]);
        *(GAS u32x4*)((bf16_t*)(p.ws + WS_CQN) + (size_t)t * QL + 8 * X.lane) = o;
        const u32x2 c = *(const GAS u32x2*)(proj + (size_t)t * INP + C_CKV + 4 * X.lane);
        float h[4] = {bflo(c.x), bfhi(c.x), bflo(c.y), bfhi(c.y)};
        ss = h[0] * h[0] + h[1] * h[1] + h[2] * h[2] + h[3] * h[3];
        rstd = rsqrtf(wave_sum(ss) * (1.f / KVL) + EPS);
        const float* g2 = p.kv_lora_g + l * KVL + 4 * X.lane;
        u32x2 o2; o2.x = cvtpk(h[0] * rstd * g2[0], h[1] * rstd * g2[1]); o2.y = cvtpk(h[2] * rstd * g2[2], h[3] * rstd * g2[3]);
        *(GAS u32x2*)((bf16_t*)(p.ws + WS_CKVN) + (size_t)t * KVL + 4 * X.lane) = o2;
    }
}
__device__ __forceinline__ void phase_prep2(const Params& p, Ctx& X, int l) {
    const bf16_t* proj = (const bf16_t*)(p.ws + WS_PROJ); const bf16_t* kvraw = (const bf16_t*)(p.ws + WS_KVRAW); bf16_t* kf = (bf16_t*)(p.ws + WS_KF);
    const float* ct = (const float*)(p.ws + WS_ROPE); const float* st = ct + SEQ * 32;
    const int lane = X.lane, hA = lane >> 4, dch = lane & 15, hR = lane >> 3, c8 = lane & 7;
    const float* kg = p.k_head_g + l * QK;
    const f32x4 gn0 = *(const GAS f32x4*)(kg + 8 * dch), gn1 = *(const GAS f32x4*)(kg + 8 * dch + 4), gr0 = *(const GAS f32x4*)(kg + 128 + 8 * c8), gr1 = *(const GAS f32x4*)(kg + 128 + 8 * c8 + 4);
    for (int t0 = X.gw; t0 < T; t0 += 4 * X.ngw) {
        int tt[4]; bool okr[4];
#pragma unroll
        for (int r = 0; r < 4; ++r) { okr[r] = t0 + r * X.ngw < T; tt[r] = okr[r] ? t0 + r * X.ngw : t0; }
        u32x4 rawA[4], rawB[4], rawR[4];
#pragma unroll
        for (int r = 0; r < 4; ++r) { const int t = tt[r];
            rawA[r] = *(const GAS u32x4*)(kvraw + (size_t)t * 2048 + hA * 256 + 8 * dch); rawB[r] = *(const GAS u32x4*)(kvraw + (size_t)t * 2048 + (hA + 4) * 256 + 8 * dch);
            rawR[r] = *(const GAS u32x4*)(proj + (size_t)t * INP + C_KR + 8 * c8); }
#pragma unroll
        for (int r = 0; r < 4; ++r) { if (!okr[r]) continue;
            const int t = tt[r], pos = t & (SEQ - 1);
            float a[8], bq[8], kr[8];
            { const u32x4 w = rawA[r]; a[0] = bflo(w.x); a[1] = bfhi(w.x); a[2] = bflo(w.y); a[3] = bfhi(w.y); a[4] = bflo(w.z); a[5] = bfhi(w.z); a[6] = bflo(w.w); a[7] = bfhi(w.w); }
            { const u32x4 w = rawB[r]; bq[0] = bflo(w.x); bq[1] = bfhi(w.x); bq[2] = bflo(w.y); bq[3] = bfhi(w.y); bq[4] = bflo(w.z); bq[5] = bfhi(w.z); bq[6] = bflo(w.w); bq[7] = bfhi(w.w); }
            { const u32x4 w = rawR[r]; kr[0] = bflo(w.x); kr[1] = bfhi(w.x); kr[2] = bflo(w.y); kr[3] = bfhi(w.y); kr[4] = bflo(w.z); kr[5] = bfhi(w.z); kr[6] = bflo(w.w); kr[7] = bfhi(w.w); }
            float sr = 0.f, sa = 0.f, sb = 0.f;
#pragma unroll
            for (int j = 0; j < 8; ++j) { sr += kr[j] * kr[j]; sa += a[j] * a[j]; sb += bq[j] * bq[j]; }
            sr += dpp_mov<0xB1>(sr); sr += dpp_mov<0x4E>(sr); sr += dpp_mov<0x141>(sr);
            sa += dpp_mov<0x128>(sa); sa += dpp_mov<0x124>(sa); sa += dpp_mov<0x122>(sa); sa += dpp_mov<0x121>(sa);
            sb += dpp_mov<0x128>(sb); sb += dpp_mov<0x124>(sb); sb += dpp_mov<0x122>(sb); sb += dpp_mov<0x121>(sb);
            const float rA = rsqrtf((sa + sr) * (1.f / QK) + EPS), rB = rsqrtf((sb + sr) * (1.f / QK) + EPS);
            { u32x4 o; o.x = cvtpk(a[0] * rA * gn0[0], a[1] * rA * gn0[1]); o.y = cvtpk(a[2] * rA * gn0[2], a[3] * rA * gn0[3]); o.z = cvtpk(a[4] * rA * gn1[0], a[5] * rA * gn1[1]); o.w = cvtpk(a[6] * rA * gn1[2], a[7] * rA * gn1[3]);
              *(GAS u32x4*)(kf + (size_t)t * 1536 + hA * QK + 8 * dch) = o; }
            { u32x4 o; o.x = cvtpk(bq[0] * rB * gn0[0], bq[1] * rB * gn0[1]); o.y = cvtpk(bq[2] * rB * gn0[2], bq[3] * rB * gn0[3]); o.z = cvtpk(bq[4] * rB * gn1[0], bq[5] * rB * gn1[1]); o.w = cvtpk(bq[6] * rB * gn1[2], bq[7] * rB * gn1[3]);
              *(GAS u32x4*)(kf + (size_t)t * 1536 + (hA + 4) * QK + 8 * dch) = o; }
            const float rsA = __int_as_float(__builtin_amdgcn_ds_bpermute(64 * (hR & 3), __float_as_int(rA))), rsB = __int_as_float(__builtin_amdgcn_ds_bpermute(64 * (hR & 3), __float_as_int(rB))); const float rs = hR < 4 ? rsA : rsB;
            const f32x4 c0 = *(const GAS f32x4*)(ct + (size_t)pos * 32 + 8 * (c8 & 3)), c1 = *(const GAS f32x4*)(ct + (size_t)pos * 32 + 8 * (c8 & 3) + 4);
            const f32x4 s0 = *(const GAS f32x4*)(st + (size_t)pos * 32 + 8 * (c8 & 3)), s1 = *(const GAS f32x4*)(st + (size_t)pos * 32 + 8 * (c8 & 3) + 4);
            float xo[8];
#pragma unroll
            for (int j = 0; j < 8; ++j) { const float x = kr[j] * (j < 4 ? gr0[j & 3] : gr1[j & 3]); const float pr = lane_xor<4>(x);
                const float c = j < 4 ? c0[j & 3] : c1[j & 3], sn = j < 4 ? s0[j & 3] : s1[j & 3];
                xo[j] = (c8 < 4 ? x * c - pr * sn : pr * sn + x * c) * rs; }
            { u32x4 o; o.x = cvtpk(xo[0], xo[1]); o.y = cvtpk(xo[2], xo[3]); o.z = cvtpk(xo[4], xo[5]); o.w = cvtpk(xo[6], xo[7]);
              *(GAS u32x4*)(kf + (size_t)t * 1536 + hR * QK + 128 + 8 * c8) = o; }
        }
    }
}
__device__ __forceinline__ void phase_onorm(const Params& p, Ctx& X, int l) {
    const bf16_t* oatt = (const bf16_t*)(p.ws + WS_OATT); bf16_t* ocat = (bf16_t*)(p.ws + WS_OCAT);
    for (int t0 = X.gw; t0 < T; t0 += 2 * X.ngw) {
        const int t1 = t0 + X.ngw; const bool two = t1 < T; const int tt[2] = {t0, two ? t1 : t0};
        u32x4 a[2][2][2];
#pragma unroll
        for (int r = 0; r < 2; ++r)
#pragma unroll
            for (int half = 0; half < 2; ++half)
#pragma unroll
                for (int j = 0; j < 2; ++j) a[r][half][j] = *(const GAS u32x4*)(oatt + (size_t)tt[r] * D + half * 1024 + 8 * X.lane + 512 * j);
#pragma unroll
        for (int r = 0; r < 2; ++r) { if (r == 1 && !two) break;
#pragma unroll
            for (int half = 0; half < 2; ++half) {
                const float* g = (half ? p.sb_out_g : p.mla_out_g) + l * 1024;
                float f[16];
#pragma unroll
                for (int j = 0; j < 2; ++j) { const u32x4 q = a[r][half][j];
                    f[8 * j + 0] = bflo(q.x); f[8 * j + 1] = bfhi(q.x); f[8 * j + 2] = bflo(q.y); f[8 * j + 3] = bfhi(q.y); f[8 * j + 4] = bflo(q.z); f[8 * j + 5] = bfhi(q.z); f[8 * j + 6] = bflo(q.w); f[8 * j + 7] = bfhi(q.w); }
                float ss = 0.f;
#pragma unroll
                for (int i = 0; i < 16; ++i) ss += f[i] * f[i];
                const float rstd = rsqrtf(wave_sum(ss) * (1.f / 1024) + EPS);
#pragma unroll
                for (int j = 0; j < 2; ++j) { const f32x4 g0 = *(const GAS f32x4*)(g + 8 * X.lane + 512 * j), g1 = *(const GAS f32x4*)(g + 8 * X.lane + 512 * j + 4); u32x4 o;
                    o.x = cvtpk(f[8 * j + 0] * rstd * g0[0], f[8 * j + 1] * rstd * g0[1]); o.y = cvtpk(f[8 * j + 2] * rstd * g0[2], f[8 * j + 3] * rstd * g0[3]);
                    o.z = cvtpk(f[8 * j + 4] * rstd * g1[0], f[8 * j + 5] * rstd * g1[1]); o.w = cvtpk(f[8 * j + 6] * rstd * g1[2], f[8 * j + 7] * rstd * g1[3]);
                    *(GAS u32x4*)(ocat + (size_t)tt[r] * D + half * 1024 + 8 * X.lane + 512 * j) = o; } } }
    }
}
__device__ __forceinline__ void route_pick(const float (&lg)[NE], const float* router_b, int& e0, int& e1, float& w0, float& w1) {
    float sc[NE], sel[NE];
#pragma unroll
    for (int e = 0; e < NE; ++e) { sc[e] = 1.f / (1.f + expf(-lg[e])); sel[e] = sc[e] + router_b[e]; }
    int gbest = 0; float gs_best = 0.f;
#pragma unroll
    for (int g = 0; g < 4; ++g) { const float a = sel[4 * g], bb = sel[4 * g + 1], c = sel[4 * g + 2], d = sel[4 * g + 3];
        const float hi1 = fmaxf(a, bb), lo1 = fminf(a, bb), hi2 = fmaxf(c, d), lo2 = fminf(c, d);
        const float top = fmaxf(hi1, hi2), second = fmaxf(fminf(hi1, hi2), fmaxf(lo1, lo2));
        const float gs = top + second;
        if (g == 0 || gs > gs_best) { gs_best = gs; gbest = g; } }
    float s4[4], c4[4];
#pragma unroll
    for (int i = 0; i < 4; ++i) { s4[i] = 0.f; c4[i] = 0.f; }
#pragma unroll
    for (int g = 0; g < 4; ++g)
#pragma unroll
        for (int i = 0; i < 4; ++i) if (gbest == g) { s4[i] = sel[4 * g + i]; c4[i] = sc[4 * g + i]; }
    int i1 = 0; float b1 = s4[0];
#pragma unroll
    for (int i = 1; i < 4; ++i) if (s4[i] > b1) { b1 = s4[i]; i1 = i; }
    int i2 = -1; float b2 = 0.f;
#pragma unroll
    for (int i = 0; i < 4; ++i) if (i != i1 && (i2 < 0 || s4[i] > b2)) { b2 = s4[i]; i2 = i; }
    float x1 = 0.f, x2 = 0.f;
#pragma unroll
    for (int i = 0; i < 4; ++i) { if (i == i1) x1 = c4[i]; if (i == i2) x2 = c4[i]; }
    const float inv = 1.f / (x1 + x2);
    e0 = gbest * 4 + i1; e1 = gbest * 4 + i2; w0 = x1 * inv; w1 = x2 * inv;
}
__device__ __forceinline__ void phase_norm2_route(const Params& p, Ctx& X, int l, const bool dm = false) {
    LAS float* rwT = (LAS float*)X.lds;
    LAS int* pk = (LAS int*)(X.lds + LDS_X);
    LAS float* lgs = (LAS float*)(X.lds + LDS_X + 1024) + X.wave * 64;
    { const char* src = (const char*)(p.ws + WS_RWT);
#pragma unroll
      for (int i = 0; i < 16; ++i) __builtin_amdgcn_global_load_lds((const unsigned*)(src + (size_t)(i * NTHR + X.tid) * 16), (LAS unsigned*)(X.lds + i * 8192 + X.wave * 1024), 16, 0, 0); }
    const float* mod = (const float*)(p.ws + WS_MOD);
    const int rows_per = ((T + X.G - 1) / X.G + 3) & ~3;
    const int t0 = X.blk * rows_per;
    const int lane = X.lane;
#pragma unroll 1
    for (int c0 = 0; c0 < rows_per; c0 += 4 * NWAVES) {
        const int rl0 = c0 + 4 * X.wave;
        int tt[4]; bool ok[4];
#pragma unroll
        for (int r = 0; r < 4; ++r) { ok[r] = (rl0 + r < rows_per) && (t0 + rl0 + r < T); tt[r] = ok[r] ? t0 + rl0 + r : (t0 < T ? t0 : 0); }
        f32x4 v[4][8];
#pragma unroll
        for (int r = 0; r < 4; ++r) { const bf16_t* xr = (const bf16_t*)(p.ws + WS_XB) + (size_t)tt[r] * D + 4 * lane;
#pragma unroll
            for (int j = 0; j < 8; ++j) { const u32x2 w = *(const GAS u32x2*)(xr + 256 * j); v[r][j] = (f32x4){bflo(w.x), bfhi(w.x), bflo(w.y), bfhi(w.y)}; } }
        float rstd[4];
#pragma unroll
        for (int r = 0; r < 4; ++r) { float ss = 0.f;
#pragma unroll
            for (int j = 0; j < 8; ++j) ss += (v[r][j][0] * v[r][j][0] + v[r][j][1] * v[r][j][1]) + (v[r][j][2] * v[r][j][2] + v[r][j][3] * v[r][j][3]);
            rstd[r] = rsqrtf(wave_sum_dpp(ss) * (1.f / D) + EPS); }
        { const int b0_ = tt[0] >> 12;
          const float* a2 = (const float*)(p.ws + WS_MOD2) + ((size_t)l * 2 + b0_) * D + 4 * lane; const float* sh2 = mod + ((size_t)l * 2 + b0_) * 12288 + 3 * D + 4 * lane;
#pragma unroll
          for (int j = 0; j < 8; ++j) { const f32x4 aa = *(const GAS f32x4*)(a2 + 256 * j), sh = *(const GAS f32x4*)(sh2 + 256 * j);
#pragma unroll
              for (int r = 0; r < 4; ++r) v[r][j] = v[r][j] * rstd[r] * aa + sh; } }
#pragma unroll
        for (int r = 0; r < 4; ++r) if (ok[r]) store_row_bf16(X, (bf16_t*)(p.ws + (dm ? WS_OCAT : WS_H)) + (size_t)tt[r] * D, v[r]);
        if (c0 == 0) { asm volatile("s_waitcnt vmcnt(0)" ::: "memory"); __syncthreads(); }
        float s[64];
#pragma unroll
        for (int i = 0; i < 64; ++i) s[i] = 0.f;
#pragma unroll
        for (int e = 0; e < NE; ++e) {
#pragma unroll
            for (int j = 0; j < 8; ++j) { const f32x4 w = *(const LAS f32x4*)(rwT + e * D + 4 * lane + 256 * j);
#pragma unroll
                for (int r = 0; r < 4; ++r) s[16 * r + e] += (v[r][j][0] * w[0] + v[r][j][1] * w[1]) + (v[r][j][2] * w[2] + v[r][j][3] * w[3]); }
            __builtin_amdgcn_sched_barrier(0); }
#pragma unroll
        for (int k = 0; k < 32; ++k) { auto rr = __builtin_amdgcn_permlane32_swap(__float_as_uint(s[k]), __float_as_uint(s[k + 32]), false, false); s[k] = __uint_as_float(rr[0]) + __uint_as_float(rr[1]); }
#pragma unroll
        for (int k = 0; k < 16; ++k) { auto rr = __builtin_amdgcn_permlane16_swap(__float_as_uint(s[k]), __float_as_uint(s[k + 16]), false, false); s[k] = __uint_as_float(rr[0]) + __uint_as_float(rr[1]); }
        { const bool b3 = (lane & 8) != 0, b2 = (lane & 4) != 0, b1 = (lane & 2) != 0, b0 = (lane & 1) != 0;
#pragma unroll
          for (int k = 0; k < 8; ++k) { const float keep = b3 ? s[k + 8] : s[k], send = b3 ? s[k] : s[k + 8]; s[k] = keep + lane_xor<8>(send); }
#pragma unroll
          for (int k = 0; k < 4; ++k) { const float keep = b2 ? s[k + 4] : s[k], send = b2 ? s[k] : s[k + 4]; s[k] = keep + lane_xor<4>(send); }
#pragma unroll
          for (int k = 0; k < 2; ++k) { const float keep = b1 ? s[k + 2] : s[k], send = b1 ? s[k] : s[k + 2]; s[k] = keep + lane_xor<2>(send); }
          { const float keep = b0 ? s[1] : s[0], send = b0 ? s[0] : s[1]; s[0] = keep + lane_xor<1>(send); } }
        lgs[lane] = s[0];
        asm volatile("s_waitcnt lgkmcnt(0)" ::: "memory");
        float lg[NE];
#pragma unroll
        for (int q = 0; q < 4; ++q) { const f32x4 t4 = *(const LAS f32x4*)(lgs + (lane >> 4) * 16 + 4 * q); lg[4 * q] = t4[0]; lg[4 * q + 1] = t4[1]; lg[4 * q + 2] = t4[2]; lg[4 * q + 3] = t4[3]; }
        int e0, e1; float w0, w1;
        route_pick(lg, p.router_b, e0, e1, w0, w1);
        const int rr_ = lane >> 4;
        if ((lane & 15) == 0 && rl0 + rr_ < 64) { const int rl = rl0 + rr_; pk[rl * 4 + 0] = e0; pk[rl * 4 + 1] = e1; pk[rl * 4 + 2] = __float_as_int(w0); pk[rl * 4 + 3] = __float_as_int(w1); }
        asm volatile("s_waitcnt lgkmcnt(0)" ::: "memory");
    }
    __syncthreads();
    const int nrows = (t0 + rows_per <= T) ? rows_per : (T - t0 > 0 ? T - t0 : 0);
    { const int e = X.tid >> 5, r = X.tid & 31, half = (X.tid >> 5) & 1;
      bool m0 = false, m1 = false; int k0 = 0, k1 = 0;
      if (r < nrows) { const int a = pk[r * 4 + 0], b = pk[r * 4 + 1]; m0 = (a == e) || (b == e); k0 = (a == e) ? 0 : 1; }
      if (r + 32 < nrows) { const int a = pk[(r + 32) * 4 + 0], b = pk[(r + 32) * 4 + 1]; m1 = (a == e) || (b == e); k1 = (a == e) ? 0 : 1; }
      const unsigned long long bal0 = __ballot(m0), bal1 = __ballot(m1);
      const unsigned h0 = half ? (unsigned)(bal0 >> 32) : (unsigned)bal0, h1 = half ? (unsigned)(bal1 >> 32) : (unsigned)bal1;
      const int n = __popc(h0) + __popc(h1);
      int base = 0;
      if (r == 0 && n) base = (int)__hip_atomic_fetch_add((unsigned*)(p.ws + WS_CTL) + CW_CNT + (dm ? 8192 : 0) + (l * 16 + e) * 64, (unsigned)n, __ATOMIC_RELAXED, __HIP_MEMORY_SCOPE_AGENT);
      { const int blo = __builtin_amdgcn_readlane(base, 0), bhi = __builtin_amdgcn_readlane(base, 32); base = half ? bhi : blo; }
      int* tok = (int*)(p.ws + (dm ? WS_KF : WS_TOK)) + e * T; int* slot = (int*)(p.ws + (dm ? WS_KF + MiB : WS_SLOT));
      const unsigned below = (1u << r) - 1u;
      if (m0) { const int t = t0 + r, pos = base + __popc(h0 & below);
          tok[pos] = t; slot[(size_t)t * 8 + 2 * k0] = e; slot[(size_t)t * 8 + 2 * k0 + 1] = pos; slot[(size_t)t * 8 + 4 + k0] = pk[r * 4 + 2 + k0]; }
      if (m1) { const int t = t0 + r + 32, pos = base + __popc(h0) + __popc(h1 & below);
          tok[pos] = t; slot[(size_t)t * 8 + 2 * k1] = e; slot[(size_t)t * 8 + 2 * k1 + 1] = pos; slot[(size_t)t * 8 + 4 + k1] = pk[(r + 32) * 4 + 2 + k1]; } }
}

__device__ __forceinline__ void phase_route2(const Params& p, Ctx& X, int l) {
    if (X.blk >= NE) return;
    const int e = X.blk; LAS int* wc = (LAS int*)(X.lds + LDS_X);
    int* slot = (int*)(p.ws + WS_SLOT); int* tok = (int*)(p.ws + WS_TOK) + e * T;
    const int tbeg = X.wave * (T / NWAVES);
    int n = 0;
    for (int c = 0; c < T / NWAVES / 64; ++c) { const int t = tbeg + c * 64 + X.lane; const bool m = (slot[(size_t)t * 8 + 0] == e) || (slot[(size_t)t * 8 + 2] == e); n += __popcll(__ballot(m)); }
    if (X.lane == 0) wc[X.wave] = n;
    __syncthreads();
    int base = 0, total = 0;
    for (int w = 0; w < NWAVES; ++w) { const int c = wc[w]; if (w < X.wave) base += c; total += c; }
    if (X.tid == 0) __hip_atomic_store((unsigned*)(p.ws + WS_CTL) + CW_CNT + (l * 16 + e) * 64, (unsigned)total, __ATOMIC_RELAXED, __HIP_MEMORY_SCOPE_AGENT);
    for (int c = 0; c < T / NWAVES / 64; ++c) { const int t = tbeg + c * 64 + X.lane; const int e0 = slot[(size_t)t * 8 + 0], e1 = slot[(size_t)t * 8 + 2]; const bool m = (e0 == e) || (e1 == e);
        const unsigned long long bal = __ballot(m); const int pos = base + __popcll(bal & ((1ull << X.lane) - 1ull));
        if (m) { tok[pos] = t; slot[(size_t)t * 8 + (e0 == e ? 1 : 3)] = pos; }
        base += __popcll(bal); }
}

__device__ __forceinline__ void phase_attn_naive(const Params& p, Ctx& X) {
    const bf16_t* qf = (const bf16_t*)(p.ws + WS_QF); const bf16_t* kf = (const bf16_t*)(p.ws + WS_KF); const bf16_t* kvraw = (const bf16_t*)(p.ws + WS_KVRAW);
    const bf16_t* proj = (const bf16_t*)(p.ws + WS_PROJ); bf16_t* oatt = (bf16_t*)(p.ws + WS_OATT);
    LAS float* qs = (LAS float*)(X.lds + X.wave * 2048); LAS float* ps = qs + 256;
    const int lane = X.lane;
    for (int it = X.gw; it < NB * NH * SEQ; it += X.ngw) {
        const int t = it % SEQ, h = (it / SEQ) % NH, b = it / (SEQ * NH);
        const bf16_t* q = qf + (size_t)(b * SEQ + t) * 1536 + h * QK;
        qs[lane] = bf2f(q[lane]); qs[64 + lane] = bf2f(q[64 + lane]); qs[128 + lane] = bf2f(q[128 + lane]);
        const int nk = 64 * ((t >> 6) + 1);
        float m = -1e30f, lsum = 0.f, o0 = 0.f, o1 = 0.f;
        for (int kb = 0; kb < nk; kb += 64) {
            const bf16_t* kr = kf + (size_t)(b * SEQ + kb + lane) * 1536 + h * QK; float s = 0.f;
#pragma unroll 4
            for (int d8 = 0; d8 < 24; ++d8) { const u32x4 a = *(const GAS u32x4*)(kr + 8 * d8); const f32x4 q0 = *(const LAS f32x4*)(qs + 8 * d8), q1 = *(const LAS f32x4*)(qs + 8 * d8 + 4);
                s += bflo(a.x) * q0[0] + bfhi(a.x) * q0[1] + bflo(a.y) * q0[2] + bfhi(a.y) * q0[3] + bflo(a.z) * q1[0] + bfhi(a.z) * q1[1] + bflo(a.w) * q1[2] + bfhi(a.w) * q1[3]; }
            const float mn = fmaxf(m, wave_max(s)); const float al = exp2f(m - mn); const float pe = exp2f(s - mn);
            lsum = lsum * al + wave_sum(pe); o0 *= al; o1 *= al; m = mn;
            ps[lane] = pe;
            const bf16_t* vb = kvraw + (size_t)(b * SEQ + kb) * 2048 + h * 256 + 128;
#pragma unroll 8
            for (int j = 0; j < 64; ++j) { const float pj = ps[j]; o0 += pj * bf2f(vb[(size_t)j * 2048 + lane]); o1 += pj * bf2f(vb[(size_t)j * 2048 + 64 + lane]); }
        }
        const float il = 1.f / lsum;
        bf16_t* o = oatt + (size_t)(b * SEQ + t) * D + h * DV;
        o[lane] = f2bf(o0 * il); o[64 + lane] = f2bf(o1 * il);
    }
    for (int it = X.gw; it < NB * NH * SEQ; it += X.ngw) {
        const int t = it % SEQ, h = (it / SEQ) % NH, b = it / (SEQ * NH);
        const bf16_t* q = proj + (size_t)(b * SEQ + t) * INP + C_SQ + h * 128;
        qs[lane] = bf2f(q[lane]); qs[64 + lane] = bf2f(q[64 + lane]);
        float carry = 1.f, o0 = 0.f, o1 = 0.f;
        for (int kb = (t > 0) ? 64 * ((t - 1) >> 6) : -64; kb >= 0; kb -= 64) {
            const int j = kb + lane; const bool valid = j < t;
            const bf16_t* kr = proj + (size_t)(b * SEQ + j) * INP + C_SK + h * 128; float s = 0.f;
#pragma unroll 4
            for (int d8 = 0; d8 < 16; ++d8) { const u32x4 a = *(const GAS u32x4*)(kr + 8 * d8); const f32x4 q0 = *(const LAS f32x4*)(qs + 8 * d8), q1 = *(const LAS f32x4*)(qs + 8 * d8 + 4);
                s += bflo(a.x) * q0[0] + bfhi(a.x) * q0[1] + bflo(a.y) * q0[2] + bfhi(a.y) * q0[3] + bflo(a.z) * q1[0] + bfhi(a.z) * q1[1] + bflo(a.w) * q1[2] + bfhi(a.w) * q1[3]; }
            const float e = valid ? exp2f(s) : 0.f; const float r = 1.f / (1.f + e);
            float sp = r;
#pragma unroll
            for (int off = 1; off < 64; off <<= 1) { const float tmp = __shfl_down(sp, off); if (lane + off < 64) sp *= tmp; }
            const float a = e * sp * carry;
            carry *= __shfl(sp, 0);
            ps[lane] = a;
            const bf16_t* vb = proj + (size_t)(b * SEQ + kb) * INP + C_SV + h * 128;
#pragma unroll 8
            for (int jj = 0; jj < 64; ++jj) { const float pj = ps[jj]; o0 += pj * bf2f(vb[(size_t)jj * INP + lane]); o1 += pj * bf2f(vb[(size_t)jj * INP + 64 + lane]); }
        }
        bf16_t* o = oatt + (size_t)(b * SEQ + t) * D + 1024 + h * 128;
        o[lane] = f2bf(o0); o[64 + lane] = f2bf(o1);
    }
}


namespace att {
constexpr int SHM_V = 64 * 128 * 2;
#define SBAR() __builtin_amdgcn_sched_barrier(0)
#define KSWZ(row, colB) ((row) * 256 + ((colB) ^ (((row) & 7) << 4)))
__device__ __forceinline__ int v_st(int k, int c) { const int kk = (k & ~0xC) | ((k & 4) << 1) | ((k & 8) >> 1); return ((kk >> 3) * 4 + (c >> 5)) * 512 + ((kk & 7) * 32 + (c & 31)) * 2; }
__device__ __forceinline__ int v_rd_base(int lane) { return ((lane & 3) << 3) | (((lane >> 2) & 3) << 6) | (((lane >> 4) & 1) << 5) | (((lane >> 5) & 1) << 8); }
constexpr int v_rd_off(int d0, int ks, int half) { return d0 * 512 + ks * 4096 + half * 2048; }
__device__ __forceinline__ int crow(int r, int hi) { return (r & 3) + 8 * (r >> 2) + 4 * hi; }
__device__ __forceinline__ bf16x8 load8(const bf16_t* p) { return *(const GAS bf16x8*)p; }

struct Blk { const bf16_t* Q; const bf16_t* K; const bf16_t* V; bf16_t* O; int P0; const float* qg; const float* ct; float* oss; int tb, nt, split, ldo; float* pml; unsigned* part; unsigned* flag; };
template <bool MLA> struct Seam { bf16x8 qr[MLA ? 12 : 8]; bf16x8 st_v0, st_v1; bf16x8 st_k[MLA ? 3 : 2]; };

__device__ __forceinline__ void mask_tile(f32x16& p0, f32x16& p1, int dq) {
    const float NEG = -__builtin_inff();
#pragma unroll
    for (int r = 0; r < 16; ++r) { const int c = (r & 3) + 8 * (r >> 2); if (dq - c < 0) p0[r] = NEG; if (dq - c - 32 < 0) p1[r] = NEG; }
}
#define PK4(P, B_, OUT) do { unsigned a0 = cvtpk(P[B_+0], P[B_+1]), a1 = cvtpk(P[B_+2], P[B_+3]);                          \
        unsigned b0 = cvtpk(P[B_+4], P[B_+5]), b1 = cvtpk(P[B_+6], P[B_+7]);                                             \
        auto r0 = __builtin_amdgcn_permlane32_swap(a0, b0, false, false); auto r1 = __builtin_amdgcn_permlane32_swap(a1, b1, false, false); \
        u32x4 w = {r0[0], r1[0], r0[1], r1[1]}; OUT = *reinterpret_cast<bf16x8*>(&w); } while (0)
__device__ __forceinline__ void partialSM(f32x16& p0, f32x16& p1, float& m_reg, float& mn, float& alpha) {
    float pmax = p0[0];
#pragma unroll
    for (int r = 1; r < 16; ++r) pmax = fmaxf(pmax, p0[r]);
#pragma unroll
    for (int r = 0; r < 16; ++r) pmax = fmaxf(pmax, p1[r]);
    { auto rr = __builtin_amdgcn_permlane32_swap(__float_as_uint(pmax), __float_as_uint(pmax), false, false); pmax = fmaxf(__uint_as_float(rr[0]), __uint_as_float(rr[1])); }
    if (__builtin_expect(__all((pmax - m_reg) <= 11.54f), 1)) { mn = m_reg; alpha = 1.f; }
    else { mn = fmaxf(m_reg, pmax); alpha = __builtin_amdgcn_exp2f(m_reg - mn); m_reg = mn; }
#pragma unroll
    for (int r = 0; r < 16; ++r) p0[r] = p0[r] - mn;
#pragma unroll
    for (int r = 0; r < 16; ++r) p1[r] = p1[r] - mn;
#pragma unroll
    for (int r = 0; r < 16; ++r) p0[r] = __builtin_amdgcn_exp2f(p0[r]);
}
__device__ __forceinline__ void finishSM(f32x16& p0, f32x16& p1, float alpha, float& l_reg, bf16x8& pa0, bf16x8& pa1, bf16x8& pa2, bf16x8& pa3) {
#pragma unroll
    for (int r = 0; r < 16; ++r) p1[r] = __builtin_amdgcn_exp2f(p1[r]);
    float ps = 0;
#pragma unroll
    for (int r = 0; r < 16; ++r) ps += p0[r];
#pragma unroll
    for (int r = 0; r < 16; ++r) ps += p1[r];
    { auto rr = __builtin_amdgcn_permlane32_swap(__float_as_uint(ps), __float_as_uint(ps), false, false); ps = __uint_as_float(rr[0]) + __uint_as_float(rr[1]); }
    l_reg = l_reg * alpha + ps;
    PK4(p0, 0, pa0); PK4(p0, 8, pa1); PK4(p1, 0, pa2); PK4(p1, 8, pa3);
}
__device__ __forceinline__ void sb_part(f32x16& p0, f32x16& p1) {
#pragma unroll
    for (int r = 0; r < 16; ++r) p0[r] = __builtin_amdgcn_exp2f(fminf(p0[r], 100.f));
#pragma unroll
    for (int r = 0; r < 16; ++r) p1[r] = __builtin_amdgcn_exp2f(fminf(p1[r], 100.f));
}
__device__ __forceinline__ void sb_block(f32x16& p, float& carry, int hi) {
    float s[16];
#pragma unroll
    for (int r = 0; r < 16; ++r) s[r] = __builtin_amdgcn_rcpf(1.f + p[r]);
#pragma unroll
    for (int g = 0; g < 4; ++g) { s[4 * g + 2] *= s[4 * g + 3]; s[4 * g + 1] *= s[4 * g + 2]; s[4 * g] *= s[4 * g + 1]; }
    float lo[4], hh[4];
#pragma unroll
    for (int g = 0; g < 4; ++g) { auto rr = __builtin_amdgcn_permlane32_swap(__float_as_uint(s[4 * g]), __float_as_uint(s[4 * g]), false, false); lo[g] = __uint_as_float(rr[0]); hh[g] = __uint_as_float(rr[1]); }
    const float X7 = carry, X6 = X7 * hh[3], X5 = X6 * lo[3], X4 = X5 * hh[2], X3 = X4 * lo[2], X2 = X3 * hh[1], X1 = X2 * lo[1], X0 = X1 * hh[0];
    carry = X0 * lo[0];
    const float m0 = hi ? X1 : X0, m1 = hi ? X3 : X2, m2 = hi ? X5 : X4, m3 = hi ? X7 : X6;
#pragma unroll
    for (int i = 0; i < 4; ++i) { p[i] = p[i] * (s[i] * m0); p[4 + i] = p[4 + i] * (s[4 + i] * m1); p[8 + i] = p[8 + i] * (s[8 + i] * m2); p[12 + i] = p[12 + i] * (s[12 + i] * m3); }
}
__device__ __forceinline__ void sb_finish(f32x16& p0, f32x16& p1, float& carry, int hi, bf16x8& pa0, bf16x8& pa1, bf16x8& pa2, bf16x8& pa3) {
    sb_block(p1, carry, hi); sb_block(p0, carry, hi);
    PK4(p0, 0, pa0); PK4(p0, 8, pa1); PK4(p1, 0, pa2); PK4(p1, 8, pa3);
}
template <bool MLA, int KB>
__device__ __forceinline__ void qkt(f32x16& p0, f32x16& p1, const LAS char* K_lds, int r32, int hi, const bf16x8* qr, const LAS bf16x8* qx, bool act) {
    constexpr int SHM_K = 64 * (MLA ? 192 : 128) * 2, NQ = MLA ? 12 : 8, PITCH = MLA ? 384 : 256, QREG = MLA ? 5 : 8;
    if (!act) { const float NEG = -__builtin_inff();
#pragma unroll
        for (int r = 0; r < 16; ++r) { p0[r] = NEG; p1[r] = NEG; } return; }
    p0 = f32x16{}; p1 = f32x16{};
    const LAS char* kb[4];
#pragma unroll
    for (int dd = 0; dd < 4; ++dd) kb[dd] = K_lds + KB * SHM_K + (MLA ? (r32 * 384 + (((2 * dd + hi) ^ ((r32 >> 1) & 7)) << 4)) : KSWZ(r32, (dd * 16 + hi * 8) * 2));
#pragma unroll
    for (int d0 = 0; d0 < NQ; ++d0) { const LAS char* a = kb[d0 & 3] + (d0 >> 2) * 128;
        bf16x8 b0 = *reinterpret_cast<const LAS bf16x8*>(a);
        bf16x8 b1 = *reinterpret_cast<const LAS bf16x8*>(a + 32 * PITCH);
        const bf16x8 q = (MLA && d0 >= QREG) ? qx[(d0 - QREG) * 64] : qr[d0 < QREG ? d0 : 0];
        p0 = __builtin_amdgcn_mfma_f32_32x32x16_bf16(b0, q, p0, 0, 0, 0);
        p1 = __builtin_amdgcn_mfma_f32_32x32x16_bf16(b1, q, p1, 0, 0, 0); }
}
template <int VB>
__device__ __forceinline__ void pv_tile(f32x16* o, int vb0, bf16x8 pa0, bf16x8 pa1, bf16x8 pa2, bf16x8 pa3, bool act) {
    if (!act) return;
#define TRRD(dst, off) asm volatile("ds_read_b64_tr_b16 %0, %1 offset:%2" : "=&v"(dst) : "v"(vb0), "i"(off) : "memory")
#define PV_D0(d0) do { s16x4 l0, l1, l2, l3, h0, h1, h2, h3; constexpr int b_ = VB * SHM_V + v_rd_off(d0, 0, 0); \
        TRRD(l0, b_); TRRD(h0, b_ + 2048); TRRD(l1, b_ + 4096); TRRD(h1, b_ + 6144); TRRD(l2, b_ + 8192); TRRD(h2, b_ + 10240); TRRD(l3, b_ + 12288); TRRD(h3, b_ + 14336); \
        asm volatile("s_waitcnt lgkmcnt(0)" ::: "memory"); SBAR();   \
        o[d0] = __builtin_amdgcn_mfma_f32_32x32x16_bf16(pa0, (bf16x8){l0[0], l0[1], l0[2], l0[3], h0[0], h0[1], h0[2], h0[3]}, o[d0], 0, 0, 0);   \
        o[d0] = __builtin_amdgcn_mfma_f32_32x32x16_bf16(pa1, (bf16x8){l1[0], l1[1], l1[2], l1[3], h1[0], h1[1], h1[2], h1[3]}, o[d0], 0, 0, 0);   \
        o[d0] = __builtin_amdgcn_mfma_f32_32x32x16_bf16(pa2, (bf16x8){l2[0], l2[1], l2[2], l2[3], h2[0], h2[1], h2[2], h2[3]}, o[d0], 0, 0, 0);   \
        o[d0] = __builtin_amdgcn_mfma_f32_32x32x16_bf16(pa3, (bf16x8){l3[0], l3[1], l3[2], l3[3], h3[0], h3[1], h3[2], h3[3]}, o[d0], 0, 0, 0); } while (0)
    PV_D0(0); PV_D0(1); PV_D0(2); PV_D0(3);
#undef PV_D0
#undef TRRD
}

constexpr int QG_LDS_OFF = 142336;
template <bool MLA> struct Geo {
    static constexpr int DQK = MLA ? 192 : 128, SHM_K = 64 * DQK * 2, LDQ = MLA ? 1536 : INP, LDK = LDQ, LDV = MLA ? 2048 : INP, LDO = D;
    static constexpr int QX_OFF = 2 * SHM_V + 2 * SHM_K + NWAVES * 64 * 4, LDS_NEED = QX_OFF + (MLA ? NWAVES * 7168 : 0);
};
#define ATT_VMW() asm volatile("s_waitcnt vmcnt(0)" ::: "memory")
#define ATT_VMWN(n) asm volatile("s_waitcnt vmcnt(%0)" :: "i"(n) : "memory")
template <bool MLA> __device__ __forceinline__ int first_kb(const Blk& c) { return MLA ? c.tb * 64 : (c.P0 / 64 + 3) * 64; }

template <bool MLA> struct Stg {
    int vg0, vg1, vst0, vst1, kg, kw;
    __device__ __forceinline__ void init(int tid) {
        const int sr = tid >> 4, sc = (tid & 15) * 8;
        vg0 = sr * Geo<MLA>::LDV + sc; vg1 = (32 + sr) * Geo<MLA>::LDV + sc; vst0 = v_st(sr, sc); vst1 = v_st(32 + sr, sc);
        if (MLA) { const int krow = tid >> 3, kch = tid & 7; kg = krow * Geo<MLA>::LDK + kch * 8; kw = krow * 384 + ((kch ^ ((krow >> 1) & 7)) << 4); }
        else { kg = sr * Geo<MLA>::LDK + sc; kw = KSWZ(sr, sc * 2); }
    }
};
#define ATT_SLOAD(Kp, Vp, kb_) do { S.st_v0 = load8((Vp) + (size_t)(kb_) * G::LDV + G_.vg0); S.st_v1 = load8((Vp) + (size_t)(kb_) * G::LDV + G_.vg1);                 \
        if (MLA) { S.st_k[0] = load8((Kp) + (size_t)(kb_) * G::LDK + G_.kg); S.st_k[1] = load8((Kp) + (size_t)(kb_) * G::LDK + G_.kg + 64); S.st_k[MLA ? 2 : 0] = load8((Kp) + (size_t)(kb_) * G::LDK + G_.kg + 128); } \
        else { S.st_k[0] = load8((Kp) + (size_t)(kb_) * G::LDK + G_.kg); S.st_k[1] = load8((Kp) + (size_t)((kb_) + 32) * G::LDK + G_.kg); } } while (0)
#define ATT_SWRITE_K(bf) do { if (MLA) { *(LAS bf16x8*)(K_lds + (bf) * G::SHM_K + G_.kw) = S.st_k[0]; *(LAS bf16x8*)(K_lds + (bf) * G::SHM_K + G_.kw + 128) = S.st_k[1]; *(LAS bf16x8*)(K_lds + (bf) * G::SHM_K + G_.kw + 256) = S.st_k[MLA ? 2 : 0]; } \
        else { *(LAS bf16x8*)(K_lds + (bf) * G::SHM_K + G_.kw) = S.st_k[0]; *(LAS bf16x8*)(K_lds + (bf) * G::SHM_K + G_.kw + 32 * 256) = S.st_k[1]; } } while (0)
#define ATT_SWRITE_V(bf) do { *(LAS bf16x8*)(V_lds + (bf) * SHM_V + G_.vst0) = S.st_v0; *(LAS bf16x8*)(V_lds + (bf) * SHM_V + G_.vst1) = S.st_v1; } while (0)

template <bool MLA>
__device__ __forceinline__ void attn_prime(const Blk& cur, LAS char* lds, Seam<MLA>& S, const int tid) {
    typedef Geo<MLA> G;
    const int wid = __builtin_amdgcn_readfirstlane(tid >> 6), lane = tid & 63, r32 = lane & 31, hi = lane >> 5;
    Stg<MLA> G_; G_.init(tid);
    LAS char* K_lds = lds + 2 * SHM_V;
    const int kb0 = first_kb<MLA>(cur);
#pragma unroll
    for (int d0 = 0; d0 < G::DQK / 16; ++d0) S.qr[d0] = load8(cur.Q + (size_t)(wid * 32 + r32) * G::LDQ + d0 * 16 + hi * 8);
    ATT_SLOAD(cur.K, cur.V, kb0);
    if constexpr (MLA) {
        const LAS float* qgl = (const LAS float*)(lds + QG_LDS_OFF);
#define UNPK8(dst, src) do { const u32x4 w_ = *reinterpret_cast<const u32x4*>(&(src)); dst[0] = bflo(w_.x); dst[1] = bfhi(w_.x); dst[2] = bflo(w_.y); dst[3] = bfhi(w_.y); dst[4] = bflo(w_.z); dst[5] = bfhi(w_.z); dst[6] = bflo(w_.w); dst[7] = bfhi(w_.w); } while (0)
#define PK8(dst, src) do { u32x4 w_; w_.x = cvtpk(src[0], src[1]); w_.y = cvtpk(src[2], src[3]); w_.z = cvtpk(src[4], src[5]); w_.w = cvtpk(src[6], src[7]); dst = *reinterpret_cast<bf16x8*>(&w_); } while (0)
        const int pos = cur.P0 + wid * 32 + r32;
        f32x4 rc[2][2], rsn[2][2];
#pragma unroll
        for (int i = 0; i < 2; ++i) { const float* cp = cur.ct + (size_t)pos * 32 + i * 16 + hi * 8; const float* sp = cp + SEQ * 32;
            rc[i][0] = *(const GAS f32x4*)cp; rc[i][1] = *(const GAS f32x4*)(cp + 4); rsn[i][0] = *(const GAS f32x4*)sp; rsn[i][1] = *(const GAS f32x4*)(sp + 4); }
        float ss = 0.f;
#pragma unroll
        for (int d0 = 0; d0 < 12; ++d0) { float f[8]; UNPK8(f, S.qr[d0]);
#pragma unroll
            for (int j = 0; j < 8; ++j) ss += f[j] * f[j]; }
        { auto rr = __builtin_amdgcn_permlane32_swap(__float_as_uint(ss), __float_as_uint(ss), false, false); ss = __uint_as_float(rr[0]) + __uint_as_float(rr[1]); }
        const float rs = rsqrtf(ss * (1.f / QK) + EPS) * QSCALE_MLA;
#pragma unroll
        for (int d0 = 0; d0 < 8; ++d0) { float f[8]; UNPK8(f, S.qr[d0]); const f32x4 g0 = *(const LAS f32x4*)(qgl + d0 * 16 + hi * 8), g1 = *(const LAS f32x4*)(qgl + d0 * 16 + hi * 8 + 4);
#pragma unroll
            for (int j = 0; j < 4; ++j) { f[j] *= rs * g0[j]; f[4 + j] *= rs * g1[j]; }
            PK8(S.qr[d0], f); asm volatile("" ::: "memory"); }
#pragma unroll
        for (int d0 = 8; d0 < 10; ++d0) { float x1[8], x2[8]; UNPK8(x1, S.qr[d0]); UNPK8(x2, S.qr[d0 + 2]);
            const f32x4 g0 = *(const LAS f32x4*)(qgl + d0 * 16 + hi * 8), g1 = *(const LAS f32x4*)(qgl + d0 * 16 + hi * 8 + 4), h0 = *(const LAS f32x4*)(qgl + (d0 + 2) * 16 + hi * 8), h1 = *(const LAS f32x4*)(qgl + (d0 + 2) * 16 + hi * 8 + 4);
            const f32x4 c0 = rc[d0 - 8][0], c1 = rc[d0 - 8][1], s0 = rsn[d0 - 8][0], s1 = rsn[d0 - 8][1];
#pragma unroll
            for (int j = 0; j < 4; ++j) { const float a = x1[j] * rs * g0[j], bb = x2[j] * rs * h0[j]; x1[j] = a * c0[j] - bb * s0[j]; x2[j] = a * s0[j] + bb * c0[j];
                const float a2 = x1[4 + j] * rs * g1[j], b2 = x2[4 + j] * rs * h1[j]; x1[4 + j] = a2 * c1[j] - b2 * s1[j]; x2[4 + j] = a2 * s1[j] + b2 * c1[j]; }
            PK8(S.qr[d0], x1); PK8(S.qr[d0 + 2], x2); asm volatile("" ::: "memory"); }
#undef UNPK8
#undef PK8
    }
    ATT_VMW(); ATT_SWRITE_K(0);
    __syncthreads();
}
template <bool MLA>
__device__ __forceinline__ void attn_block(const Blk& cur, LAS char* lds, Seam<MLA>& S, const int tid) {
    typedef Geo<MLA> G;
    const int wid = __builtin_amdgcn_readfirstlane(tid >> 6), lane = tid & 63, r32 = lane & 31, hi = lane >> 5;
    const int NT = MLA ? cur.nt : cur.P0 / 64 + 4;
    const int qlo = cur.P0 + wid * 32, qm = qlo + r32 - 4 * hi - 1;
    LAS char* V_lds = lds; LAS char* K_lds = lds + 2 * SHM_V;
    LAS float* wsl = (LAS float*)(lds + 2 * SHM_V + 2 * G::SHM_K) + wid * 64; LAS float* li_l = wsl; LAS float* al_l = wsl + 32;
    float m_reg = -1e30f, l_reg = 0.f, carry = 1.f; f32x16 o[4] = {};
    Stg<MLA> G_; G_.init(tid);
    const int vb0 = (int)(size_t)V_lds + v_rd_base(lane);
    const bf16_t* Kh = cur.K; const bf16_t* Vh = cur.V;
#define RESC(a) do { if (MLA) { if (__any((a) < 1.f)) { if (hi == 0) al_l[r32] = (a); asm volatile("s_waitcnt lgkmcnt(0)" ::: "memory");              \
                     for (int d_ = 0; d_ < 4; ++d_) for (int r = 0; r < 16; ++r) o[d_][r] *= al_l[crow(r, hi)]; } } } while (0)
#define KBASE(t) (MLA ? (cur.tb + (t)) * 64 : (NT - 1 - (t)) * 64)
#define ACT(t) (MLA ? (KBASE(t) <= qlo) : (!alldone && KBASE(t) <= qlo + 30))
#define MASKT(P0_, P1_, t) do { if (!MLA) { const int kb_ = KBASE(t); if (ACT(t) && kb_ + 63 >= qlo) mask_tile(P0_, P1_, qm - kb_); } } while (0)
#define PART(P0_, P1_, mnX, alX) do { if (MLA) partialSM(P0_, P1_, m_reg, mnX, alX); else sb_part(P0_, P1_); } while (0)
#define FINISH(P0_, P1_, alY) do { if (MLA) finishSM(P0_, P1_, alY, l_reg, pa0, pa1, pa2, pa3); else sb_finish(P0_, P1_, carry, hi, pa0, pa1, pa2, pa3); } while (0)
    f32x16 pA0, pA1, pB0, pB1; float mnA = 0.f, mnB = 0.f, alA = 1.f, alB = 1.f; bf16x8 pa0, pa1, pa2, pa3;
    LAS int* dflag = (LAS int*)(lds + G::QX_OFF); bool alldone = false;
#define SB_PUB(tp) do { if (!MLA) { const bool dn_ = ACT(tp) && ACT((tp) - 2) && __all(carry < 1.0e-6f); if (lane == 0) dflag[wid] = dn_ ? 1 : 0; } } while (0)
#define SB_CHK() do { if (!MLA) { const u32x4 f0_ = *(const LAS u32x4*)dflag, f1_ = *(const LAS u32x4*)(dflag + 4); \
        alldone = (f0_.x & f0_.y & f0_.z & f0_.w & f1_.x & f1_.y & f1_.z & f1_.w) != 0u; } } while (0)
    LAS bf16x8* qx = (LAS bf16x8*)(lds + G::QX_OFF) + wid * 448 + lane;
    if (MLA) {
#pragma unroll
        for (int i = 0; i < 7; ++i) qx[i * 64] = S.qr[(MLA ? 5 : 0) + i]; }
    ATT_SWRITE_V(0); SBAR();
    ATT_SLOAD(Kh, Vh, KBASE(1));
    SBAR(); qkt<MLA, 0>(pA0, pA1, K_lds, r32, hi, S.qr, qx, ACT(0));
    MASKT(pA0, pA1, 0); PART(pA0, pA1, mnA, alA);
    ATT_VMW(); ATT_SWRITE_V(1); ATT_SWRITE_K(1);
    __syncthreads();
#define HALF_STEP(PX0, PX1, mnX, alX, PY0, PY1, alY, t, KB, VB, SB_) do {                                                      \
        SBAR(); qkt<MLA, KB>(PX0, PX1, K_lds, r32, hi, S.qr, qx, ACT(t));                                                         \
        FINISH(PY0, PY1, alY); SBAR(); SB_PUB((t) - 1);                                                                       \
        if ((t) + 1 < NT && !alldone) { ATT_SLOAD(Kh, Vh, KBASE((t) + 1)); SBAR(); }                                          \
        pv_tile<VB>(o, vb0, pa0, pa1, pa2, pa3, ACT((t) - 1)); MASKT(PX0, PX1, (t)); PART(PX0, PX1, mnX, alX);                \
        __syncthreads(); SB_CHK();                                                                                            \
        if ((t) + 1 < NT && !alldone) { ATT_VMW(); ATT_SWRITE_V(SB_); ATT_SWRITE_K(SB_); }                                    \
        RESC(alX); __syncthreads(); } while (0)
    for (int t = 1; t + 1 < NT && !alldone; t += 2) {
        HALF_STEP(pB0, pB1, mnB, alB, pA0, pA1, alA, t, 1, 0, 0);
        HALF_STEP(pA0, pA1, mnA, alA, pB0, pB1, alB, t + 1, 0, 1, 1);
    }
    SBAR(); qkt<MLA, 1>(pB0, pB1, K_lds, r32, hi, S.qr, qx, ACT(NT - 1)); SBAR();
    FINISH(pA0, pA1, alA); SBAR();
    pv_tile<0>(o, vb0, pa0, pa1, pa2, pa3, ACT(NT - 2));
    MASKT(pB0, pB1, NT - 1); PART(pB0, pB1, mnB, alB); __syncthreads(); RESC(alB);
    FINISH(pB0, pB1, alB); SBAR(); pv_tile<1>(o, vb0, pa0, pa1, pa2, pa3, ACT(NT - 1));
    if constexpr (MLA) {
        if (cur.split == 1) {
            if (tid == 0) { while (__hip_atomic_load(cur.flag, __ATOMIC_RELAXED, __HIP_MEMORY_SCOPE_AGENT) == 0u) __builtin_amdgcn_s_sleep(4); }
            if (wid == 0) { __builtin_amdgcn_fence(__ATOMIC_ACQUIRE, "agent"); asm volatile("s_waitcnt vmcnt(0)" ::: "memory"); }
            __syncthreads();
            const f32x2 ml2 = *(const GAS f32x2*)(cur.pml + (size_t)(wid * 32 + r32) * 2);
            const float M = fmaxf(m_reg, ml2[0]), w1 = __builtin_amdgcn_exp2f(m_reg - M), w2 = ml2[1] * __builtin_amdgcn_exp2f(ml2[0] - M);
            l_reg = l_reg * w1 + w2;
            if (hi == 0) { li_l[r32] = w1; al_l[r32] = w2; } asm volatile("s_waitcnt lgkmcnt(0)" ::: "memory");
            const GAS u32x4* pp = (const GAS u32x4*)(cur.part + (size_t)(wid * 64 + lane) * 32);
#pragma unroll
            for (int q = 0; q < 8; ++q) { const u32x4 w = pp[q]; const int d0 = q >> 1, rb = (q & 1) * 8;
                const unsigned ww[4] = {w.x, w.y, w.z, w.w};
#pragma unroll
                for (int i = 0; i < 4; ++i) { const int ra = rb + 2 * i, rc = ra + 1;
                    o[d0][ra] = o[d0][ra] * li_l[crow(ra, hi)] + bflo(ww[i]) * al_l[crow(ra, hi)];
                    o[d0][rc] = o[d0][rc] * li_l[crow(rc, hi)] + bfhi(ww[i]) * al_l[crow(rc, hi)]; } }
            asm volatile("s_waitcnt lgkmcnt(0)" ::: "memory"); } }
    float rli[16];
    if (MLA) { if (hi == 0) li_l[r32] = l_reg; asm volatile("s_waitcnt lgkmcnt(0)" ::: "memory");
#pragma unroll
        for (int r = 0; r < 16; ++r) rli[r] = __builtin_amdgcn_rcpf(li_l[crow(r, hi)]); }
    else {
#pragma unroll
        for (int r = 0; r < 16; ++r) rli[r] = 1.f; }
    const bool prod = MLA && cur.split == 2;
    bf16_t* Ow = cur.O + (size_t)(wid * 32) * G::LDO;
    float* ossw = cur.oss + (size_t)(wid * 32) * 16;
#pragma unroll
    for (int r = 0; r < 16; ++r) {
#pragma unroll
        for (int d0 = 0; d0 < 4; ++d0) o[d0][r] *= rli[r];
        float sq = (o[0][r] * o[0][r] + o[1][r] * o[1][r]) + (o[2][r] * o[2][r] + o[3][r] * o[3][r]);
        sq += dpp_mov<0x128>(sq); sq += dpp_mov<0x124>(sq); sq += dpp_mov<0x122>(sq); sq += dpp_mov<0x121>(sq); sq = quarter_sum(sq);
        if (r32 == 0 && !prod) ((GAS float*)ossw)[(4 * hi + (r & 3) + 8 * (r >> 2)) * 16] = sq;
        asm volatile("" ::: "memory"); }
    if (prod) {
        GAS u32x4* pp = (GAS u32x4*)(cur.part + (size_t)(wid * 64 + lane) * 32);
#pragma unroll
        for (int q = 0; q < 8; ++q) { const int d0 = q >> 1, rb = (q & 1) * 8; u32x4 w;
            w.x = cvtpk(o[d0][rb], o[d0][rb + 1]); w.y = cvtpk(o[d0][rb + 2], o[d0][rb + 3]); w.z = cvtpk(o[d0][rb + 4], o[d0][rb + 5]); w.w = cvtpk(o[d0][rb + 6], o[d0][rb + 7]); pp[q] = w; }
        if (hi == 0) { f32x2 ml; ml[0] = m_reg; ml[1] = l_reg; *(GAS f32x2*)(cur.pml + (size_t)(wid * 32 + r32) * 2) = ml; }
        asm volatile("s_waitcnt vmcnt(0)" ::: "memory");
    } else {
#pragma unroll
        for (int r = 0; r < 16; ++r) { const int orow = crow(r, hi);
#pragma unroll
            for (int d0 = 0; d0 < 4; ++d0) { const float v = o[d0][r]; const float vn = lane_xor<1>(v);
                if ((r32 & 1) == 0) *(GAS unsigned*)(Ow + (size_t)orow * G::LDO + d0 * 32 + r32) = cvtpk(v, vn); } } }
    __syncthreads();
    if (prod && tid == 0) { __builtin_amdgcn_fence(__ATOMIC_RELEASE, "agent"); asm volatile("s_waitcnt vmcnt(0)" ::: "memory"); __hip_atomic_store(cur.flag, 1u, __ATOMIC_RELAXED, __HIP_MEMORY_SCOPE_AGENT); }
#undef SB_PUB
#undef SB_CHK
#undef RESC
#undef KBASE
#undef ACT
#undef MASKT
#undef PART
#undef FINISH
#undef HALF_STEP
}
}

__device__ const unsigned char ATT_DEAL[16][3] = {{2,31,255},{6,41,255},{27,49,51},{3,30,255},{47,62,255},{43,55,61},{42,59,63},{26,50,58},{5,56,60},{25,53,54},{7,48,255},{24,28,255},{1,44,52},{0,46,57},{4,45,255},{29,40,255}};
__device__ __forceinline__ void phase_attn(const Params& p, Ctx& X, int l) {
    LAS char* lds = (LAS char*)X.lds;
    const bf16_t* proj = (const bf16_t*)(p.ws + WS_PROJ); bf16_t* oatt = (bf16_t*)(p.ws + WS_OATT);
    { const bf16_t* qf = (const bf16_t*)(p.ws + WS_QRAW); const bf16_t* kf = (const bf16_t*)(p.ws + WS_KF); const bf16_t* kvraw = (const bf16_t*)(p.ws + WS_KVRAW);
      auto mk = [&](int L, int code) { const int bh = 2 * (L & 7) + ((L >> 3) & 1), kind = code >> 4, qb = code & 15, b = bh >> 3, h = bh & 7; att::Blk k;
          k.qg = p.q_head_g + l * QK; k.ct = (const float*)(p.ws + WS_ROPE);
          k.Q = qf + (size_t)(b * SEQ + qb * 256) * 1536 + h * QK; k.K = kf + (size_t)(b * SEQ) * 1536 + h * QK; k.V = kvraw + (size_t)(b * SEQ) * 2048 + h * 256 + 128;
          k.P0 = qb * 256; k.oss = (float*)(p.ws + WS_QF) + (size_t)(b * SEQ + qb * 256) * 16 + h;
          const int ntf = 4 * qb + 4; k.split = kind; k.nt = kind ? ntf / 2 : ntf; k.tb = kind == 2 ? ntf / 2 : 0; k.ldo = D;
          k.O = oatt + (size_t)(b * SEQ + qb * 256) * D + h * DV;
          const int item = bh * 8 + (qb & 7);
          k.part = (unsigned*)(p.ws + WS_OCAT) + (size_t)item * 16384; k.pml = (float*)(p.ws + WS_CKVN + MiB) + (size_t)item * 512; k.flag = (unsigned*)(p.ws + WS_CTL) + CW_FLG + (l * 128 + item) * 16;
          return k; };
      if (X.tid < QK) ((LAS float*)(lds + att::QG_LDS_OFF))[X.tid] = p.q_head_g[l * QK + X.tid];
      __syncthreads();
#ifndef MK_NO_MLA
#pragma unroll 1
      for (int pass = 0; pass < 3; ++pass)
      for (int L = X.blk; L < 256; L += X.G)
#pragma unroll 1
          for (int it = 0; it < 3; ++it) { const int code = ATT_DEAL[L >> 4][it]; if (code >= 48) continue;
              if ((code >> 4) != (pass == 0 ? 2 : pass == 1 ? 0 : 1)) continue;
              int tid_ = X.tid; asm volatile("" : "+v"(tid_));
              att::Seam<true> S; const att::Blk cur = mk(L, code); att::attn_prime<true>(cur, lds, S, tid_); att::attn_block<true>(cur, lds, S, tid_); }
#endif
    }
    __syncthreads();
    X.tid = X.wave * 64 + lane_id_volatile();
    { auto mk = [&](int L, int code) { const int bh = 2 * (L & 7) + ((L >> 3) & 1), qb = code & 15, b = bh >> 3, h = bh & 7; att::Blk k;
          k.Q = proj + (size_t)(b * SEQ + qb * 256) * INP + C_SQ + h * 128; k.K = proj + (size_t)(b * SEQ) * INP + C_SK + h * 128; k.V = proj + (size_t)(b * SEQ) * INP + C_SV + h * 128;
          k.O = oatt + (size_t)(b * SEQ + qb * 256) * D + 1024 + h * 128; k.P0 = qb * 256; k.qg = nullptr; k.ct = nullptr; k.oss = (float*)(p.ws + WS_QF) + (size_t)(b * SEQ + qb * 256) * 16 + 8 + h;
          k.tb = 0; k.nt = 0; k.split = 0; k.ldo = D; k.pml = nullptr; k.part = nullptr; k.flag = nullptr; return k; };
#ifndef MK_NO_SB
      for (int L = X.blk; L < 256; L += X.G)
#pragma unroll 1
          for (int it = 0; it < 3; ++it) { const int code = ATT_DEAL[L >> 4][it]; if (code < 48 || code == 255) continue;
              int tid_ = X.tid; asm volatile("" : "+v"(tid_));
              att::Seam<false> S; const att::Blk cur = mk(L, code); att::attn_prime<false>(cur, lds, S, tid_); att::attn_block<false>(cur, lds, S, tid_); }
#endif
    }
    __syncthreads();
}

__device__ __forceinline__ void cv_batch(const Params& p, Ctx& X, int b) {
    const int q = b + X.wave;
    if (q < (DEPTH - 1) * CV_NL) conv_item(p, p.ws, 1 + q / CV_NL, q % CV_NL, (LAS bf16_t*)(X.lds + 16384 + X.wave * 10240), X.lane);
}
__device__ __forceinline__ void cv_drain(const Params& p, Ctx& X, const bool t0, int limit) {
    unsigned* qc = (unsigned*)(p.ws + WS_CTL) + CW_CVQ; volatile LAS int* bq = (volatile LAS int*)(X.lds + 8192);
    for (;;) {
        if (t0) { int b = -1; if ((int)xb_ld(qc) < limit) { b = (int)xb_add(qc, 32u); if (b >= (DEPTH - 1) * CV_NL) b = -1; } bq[0] = b; }
        __syncthreads();
        const int b = bq[0];
        __syncthreads();
        if (b < 0) break;
#pragma unroll 1
        for (int i = 0; i < 4; ++i) cv_batch(p, X, b + 8 * i);
    }
}
__device__ __forceinline__ void seam_convert(const Params& p, Ctx& X, const XcdBarrier& bar, const bool t0, int quota) {
    xcd_barrier(bar, t0, 1);
    unsigned* qc = (unsigned*)(p.ws + WS_CTL) + CW_CVQ; volatile LAS int* bq = (volatile LAS int*)(X.lds + 8192);
    for (;;) {
        if (t0) { int b = -1;
            if (quota > 0 && bar.st[3] == 0u && xb_ld(&bar.bar[XB_XGEN(bar.x)]) == bar.st[2] && (int)xb_ld(qc) < (DEPTH - 1) * CV_NL) { b = (int)xb_add(qc, 8u); if (b >= (DEPTH - 1) * CV_NL) b = -1; }
            bq[0] = b; }
        __syncthreads();
        const int b = bq[0];
        __syncthreads();
        if (b < 0) break;
        cv_batch(p, X, b); --quota;
    }
    xcd_barrier(bar, t0, 2);
}

constexpr int PH_PRO = 0, PH_MOD = 1, PH_L0 = 2, PH_PER_L = 9, PH_FINAL = PH_L0 + DEPTH * PH_PER_L, PH_COUNT = PH_FINAL + 1;

__global__ void __launch_bounds__(NTHR, 2) mk_fwd(Params p_) {
    extern __shared__ __attribute__((aligned(16))) unsigned char lds_raw[];
    const int wave0 = __builtin_amdgcn_readfirstlane((int)threadIdx.x >> 6);
#define MKTID() (wave0 * 64 + lane_id_volatile())
    Ctx X_; X_.lds = (LAS unsigned char*)lds_raw; X_.tid = MKTID(); X_.lane = X_.tid & 63; X_.wave = wave0;
    X_.G = gridDim.x; X_.blk = blockIdx.x; X_.gw = X_.blk * NWAVES + X_.wave; X_.ngw = X_.G * NWAVES;
#if MK_ONE_LAUNCH
    volatile LAS unsigned* bst = (volatile LAS unsigned*)(X_.lds + LDS_BYTES - 16);
    if (MKTID() == 0) { bst[0] = 0u; bst[1] = 0u; bst[2] = 0u; bst[3] = 0u; }
    __syncthreads();
    XcdBarrier bar = xcd_barrier_post((unsigned*)(p_.ws + WS_CTL) + CW_BAR, bst, MKTID() == 0);
#define SEAM() xcd_barrier(bar, MKTID() == 0)
#define SEAM_MODE(m) xcd_barrier(bar, MKTID() == 0, (m))
#define SEAMC(quota_) do { const int qq_ = (quota_); if (l < DEPTH - 1 && qq_ > 0) seam_convert(p, X, bar, MKTID() == 0, qq_); else SEAM(); } while (0)
#else
#define SEAM() do {} while (0)
#define SEAM_MODE(m) do {} while (0)
#define SEAMC(quota_) do {} while (0)
#endif
    const int lo = p_.ph_lo, hi = p_.ph_hi;
#ifdef MK_SKIP_MOE
#define DIAGT(ty) (((ty) < 10 || (ty) == 13) && (ty) != 14)
#elif defined(MK_DIAG_PH)
#define DIAGT(ty) ((ty) == MK_DIAG_PH)
#elif defined(MK_DIAG_MASK)
#define DIAGT(ty) (((MK_DIAG_MASK) >> (ty)) & 1)
#else
#define DIAGT(ty) true
#endif
#ifndef MK_DUP_MASK
#define MK_DUP_MASK 0
#endif
#define NREP(ty) ((((MK_DUP_MASK) >> (ty)) & 1) ? 2 : 1)
#define IN(k) (sgpr_launder(lo) <= (k) && (k) < sgpr_launder(hi))
#define BOTH(k) (IN(k) && IN((k) + 1))
#define FRESH0() do { X_.tid = MKTID(); asm volatile("" : "+v"(X_.tid)); X_.lane = X_.tid & 63; X_.wave = wave0; X_.gw = X_.blk * NWAVES + wave0; asm volatile("" : "+s"(X_.gw)); } while (0)
    if (DIAGT(0) && IN(PH_PRO)) for (int rep_ = 0; rep_ < NREP(0); ++rep_) { FRESH0(); phase_prologue(p_, X_); if (BOTH(PH_PRO)) SEAM(); }
    if (DIAGT(1) && IN(PH_MOD)) { FRESH0(); phase_modreduce(p_, X_); if (BOTH(PH_MOD)) SEAM(); }
#pragma unroll 1
    for (int li = 0; li < DEPTH; ++li) {
        int l = li; asm volatile("" : "+s"(l));
        const int P0 = PH_L0 + l * PH_PER_L;
        Params p = p_; Ctx X; X.lds = X_.lds; X.G = X_.G; X.blk = X_.blk; X.ngw = X_.ngw;
        asm volatile("" : "+s"(p.ws), "+s"(p.out));
        X.tid = MKTID(); asm volatile("" : "+v"(X.tid));
        X.lane = X.tid & 63; X.wave = wave0; X.gw = X.blk * NWAVES + X.wave;
        unsigned char* ws = p.ws; const float* mod = (const float*)(ws + WS_MOD);
#define FRESH() do { X.tid = MKTID(); asm volatile("" : "+v"(X.tid)); asm volatile("" : "+s"(p.ws), "+s"(p.out)); X.lane = X.tid & 63; X.wave = wave0; \
        X.gw = X.blk * NWAVES + X.wave; asm volatile("" : "+s"(X.gw)); ws = p.ws; mod = (const float*)(ws + WS_MOD); } while (0)
#ifdef MK_EXTRA_BAR
        for (int xb_ = 0; xb_ < sgpr_launder(MK_EXTRA_BAR); ++xb_) SEAM();
#endif
        if (DIAGT(2) && IN(P0 + 0)) for (int rep_ = 0; rep_ < NREP(2); ++rep_) { FRESH(); phase_norm1(p, X, l); if (BOTH(P0 + 0)) SEAMC(0);
#ifdef MK_PROBE_N1
            if (l > 0) { FRESH(); phase_norm1(p, X, l, true); SEAM(); }
#endif
        }
        if (DIAGT(3) && IN(P0 + 1)) for (int rep_ = 0; rep_ < NREP(3); ++rep_) { FRESH();
            GemmA g{(const bf16_t*)(ws + WS_H), D, D}; RegSched S; S.init(T, INP, D, (const bf16_t*)(ws + WS_WIN) + (size_t)l * INP * D, X.G, X.blk);
            EpiInProj E{(bf16_t*)(ws + WS_PROJ), (float*)(ws + WS_CQN)};
            gemm_run(X, g, S, E);
            if (BOTH(P0 + 1)) SEAMC(0); }
        if (DIAGT(5) && IN(P0 + 2)) for (int rep_ = 0; rep_ < NREP(5); ++rep_) { FRESH();
            { GemmA g{(const bf16_t*)(ws + WS_PROJ) + C_CQ, INP, QL}; RegSched S; S.init(T, 1536, QL, (const bf16_t*)(ws + WS_WUQ) + (size_t)l * 1536 * QL, X.G, X.blk);
              EpiScaleBf16 E{(bf16_t*)(ws + WS_QRAW), 1536, (const float*)(ws + WS_CQN), 0, 8, 1.f / QL}; gemm_run(X, g, S, E); }
            FRESH();
            { GemmA g{(const bf16_t*)(ws + WS_PROJ) + C_CKV, INP, KVL}; RegSched S; S.init(T, 2048, KVL, (const bf16_t*)(ws + WS_WUKV) + (size_t)l * 2048 * KVL, X.G, X.G - 1 - X.blk);
              EpiKV E{ws, p.k_head_g + l * QK}; gemm_run(X, g, S, E); }
            if (BOTH(P0 + 2)) SEAMC(X.blk >= 192 ? 3 : 0); }
        if (DIAGT(7) && IN(P0 + 3)) for (int rep_ = 0; rep_ < NREP(7); ++rep_) { FRESH();
#if MK_NAIVE_ATTN == 2
            { const bf16_t* kvraw = (const bf16_t*)(ws + WS_KVRAW); const bf16_t* proj = (const bf16_t*)(ws + WS_PROJ); bf16_t* oatt = (bf16_t*)(ws + WS_OATT);
              for (int i = X.blk * NTHR + X.tid; i < T * 1024; i += X.G * NTHR) { const int t = i >> 10, c = i & 1023, h = c >> 7, d = c & 127;
                  oatt[(size_t)t * D + c] = kvraw[(size_t)t * 2048 + h * 256 + 128 + d]; oatt[(size_t)t * D + 1024 + c] = proj[(size_t)t * INP + C_SV + c]; } }
#elif MK_NAIVE_ATTN == 1
            phase_attn_naive(p, X);
#else
            phase_attn(p, X, l);
#endif
            if (BOTH(P0 + 3)) SEAMC((int)((0x0000043112140001ull >> (4 * ((X.blk >> 4) & 15))) & 15ull)); }
        if (DIAGT(9) && IN(P0 + 4)) for (int rep_ = 0; rep_ < NREP(9); ++rep_) { FRESH();
            GemmA g{(const bf16_t*)(ws + WS_OATT), D, D}; RegSched S; S.init(T, D, D, (const bf16_t*)(ws + WS_WO) + (size_t)l * D * D, X.G, X.blk);
#ifdef MK_PROBE_O
            { EpiResid E0{p.out, p.out, mod + (size_t)l * 2 * 12288 + 2 * D, (bf16_t*)(ws + WS_XB), (const float*)(ws + WS_QF), (bf16_t*)(ws + WS_OCAT)}; gemm_run(X, g, S, E0); SEAM(); FRESH(); }
#endif
            EpiResid E{p.out, p.out, mod + (size_t)l * 2 * 12288 + 2 * D, (bf16_t*)(ws + WS_XB), (const float*)(ws + WS_QF), (bf16_t*)(ws + WS_XB)};
            gemm_run(X, g, S, E);
            if (BOTH(P0 + 4)) SEAMC(0); }
        if (DIAGT(10) && IN(P0 + 5)) for (int rep_ = 0; rep_ < NREP(10); ++rep_) { FRESH();
#ifdef MK_PROBE_N2R
            phase_norm2_route(p, X, l, true); SEAM(); FRESH();
#endif
            phase_norm2_route(p, X, l); if (BOTH(P0 + 5)) SEAMC(0); }
        if (DIAGT(11)) {
#pragma unroll 1
          for (int sub_ = 0; sub_ < 3; ++sub_) { int sb = sub_; asm volatile("" : "+s"(sb));
            if (IN(P0 + 6 + sb)) { FRESH();
              LAS int* cnt = (LAS int*)(X.lds + LDS_X); LAS int* rb = cnt + 16; load_counts(p, X, l, cnt, rb);
              int R = 0;
#pragma unroll 1
              for (int e = 0; e < NE; ++e) R += (cnt[e] + 255) >> 8;
              const int BIG = 1 << 30, rt1 = X.G / 4, nover = R * 4 > X.G ? R * 4 - X.G : 0;
              const bool flow = nover < X.G;
              const bool two = flow && X.blk < nover;
              unsigned* guf = (unsigned*)(ws + WS_CTL) + CW_GUF + l * 128 * 16;
              { GemmA g{(const bf16_t*)(ws + WS_H), D, D};
                MoeSched S{cnt, 4, X.G, X.blk, D, (const bf16_t*)(ws + WS_WGU) + (size_t)l * NE * 1024 * D, (size_t)1024 * D, (const int*)(ws + WS_TOK), sb == 0 ? 0 : X.G, sb == 0 ? X.G : (sb == 1 ? BIG : 0)};
                EpiGU E{(bf16_t*)(ws + WS_ACT)};
                gemm_run(X, g, S, E); }
              if (sb == 1 && flow) {
                  if (two) {
                      if (MKTID() == 0) { __builtin_amdgcn_fence(__ATOMIC_RELEASE, "agent"); asm volatile("s_waitcnt vmcnt(0)" ::: "memory");
                          for (int L = X.G + X.blk; L < R * 4; L += X.G) __hip_atomic_fetch_add(guf + (L >> 2) * 16, 1u, __ATOMIC_RELAXED, __HIP_MEMORY_SCOPE_AGENT); }
                      SEAM_MODE(2); } }
              const int c2 = X.G - 1 - X.blk;
              if (sb == 2 && flow) {
                  if (MKTID() == 0) { for (int L = rt1 * 8 + c2; L < R * 8; L += X.G) { int sp = 0;
                          while (__hip_atomic_load(guf + (L >> 3) * 16, __ATOMIC_RELAXED, __HIP_MEMORY_SCOPE_AGENT) < 4u && ++sp < 400000) __builtin_amdgcn_s_sleep(8); } }
                  if (wave0 == 0) { __builtin_amdgcn_fence(__ATOMIC_ACQUIRE, "agent"); asm volatile("s_waitcnt vmcnt(0)" ::: "memory"); }
                  __syncthreads(); }
              FRESH();
              { GemmA g{(const bf16_t*)(ws + WS_ACT), DE, DE};
                const bool part = sb == 1 && nover < X.G;
                MoeSched S{cnt, 8, part ? X.G - nover : X.G, part ? X.blk - nover : (sb == 2 && flow ? c2 : X.blk), DE, (const bf16_t*)(ws + WS_WDN) + (size_t)l * NE * D * DE, (size_t)D * DE, nullptr,
                           sb == 2 ? rt1 * 8 : 0, sb == 0 || (part && X.blk < nover) ? 0 : (sb == 1 ? rt1 * 8 : BIG)};
                EpiStoreBf16 E{(bf16_t*)(ws + WS_Y), D};
                gemm_run(X, g, S, E); }
              if (BOTH(P0 + 6 + sb)) {
                  if (sb == 2) { if (l < DEPTH - 1) cv_drain(p, X, MKTID() == 0, (l + 1) * CV_NL); SEAMC(0); }
                  else if (!flow) SEAM(); else if (sb == 0) SEAM_MODE(two ? 1 : 0); } } } }
    }
    if (DIAGT(13) && IN(PH_FINAL)) { FRESH0(); phase_norm1(p_, X_, DEPTH); }
#undef IN
#undef BOTH
#undef SEAM
#undef SEAM_MODE
#undef SEAMC
}

extern "C" void kernel_launch(void* const* d_in, const int* in_sizes, int n_in, void* d_out, int out_size, void* d_ws, size_t ws_size, hipStream_t stream) {
    static int grid = 0;
    if (grid == 0) {
        if (n_in != 21 || in_sizes[0] != T * D || out_size != T * D || ws_size < WS_END) {
            fprintf(stderr, "kernel_launch: unexpected shapes (n_in %d, in0 %d, out %d, ws %zu, need %zu); nothing launched\n", n_in, n_in > 0 ? in_sizes[0] : -1, out_size, ws_size, (size_t)WS_END); grid = -1; return; }
        int dev = 0, cus = 0, per_cu = 0;
        if (hipGetDevice(&dev) != hipSuccess || hipDeviceGetAttribute(&cus, hipDeviceAttributeMultiprocessorCount, dev) != hipSuccess) { grid = -1; return; }
        if (hipFuncSetAttribute((const void*)mk_fwd, hipFuncAttributeMaxDynamicSharedMemorySize, LDS_BYTES) != hipSuccess) { fprintf(stderr, "kernel_launch: hipFuncSetAttribute failed\n"); grid = -1; return; }
        if (hipOccupancyMaxActiveBlocksPerMultiprocessor(&per_cu, (const void*)mk_fwd, NTHR, LDS_BYTES) != hipSuccess || per_cu < 1)
            fprintf(stderr, "kernel_launch: occupancy query reports %d workgroups per CU\n", per_cu);
        (void)hipGetLastError();
        grid = cus;
    }
    if (grid < 0) return;
    (void)hipMemsetAsync((char*)d_ws + WS_CTL, 0, CTL_BYTES, stream);
#ifdef MK_PROBE_POISON
    (void)hipMemsetAsync((char*)d_ws + MK_PROBE_LO * MiB, 0xAA, (size_t)(MK_PROBE_HI - MK_PROBE_LO) * MiB, stream);
    (void)hipMemsetAsync(d_out, 0xAA, (size_t)T * D * 4, stream);
#endif
    Params p{};
    p.x = (const float*)d_in[0]; p.c = (const float*)d_in[1]; p.norm1_g = (const float*)d_in[2]; p.norm2_g = (const float*)d_in[3]; p.w_ada = (const float*)d_in[4]; p.b_ada = (const float*)d_in[5];
    p.w_in = (const float*)d_in[6]; p.q_lora_g = (const float*)d_in[7]; p.kv_lora_g = (const float*)d_in[8]; p.w_uq = (const float*)d_in[9]; p.w_ukv = (const float*)d_in[10];
    p.q_head_g = (const float*)d_in[11]; p.k_head_g = (const float*)d_in[12]; p.mla_out_g = (const float*)d_in[13]; p.sb_out_g = (const float*)d_in[14]; p.w_o = (const float*)d_in[15];
    p.router_w = (const float*)d_in[16]; p.router_b = (const float*)d_in[17]; p.w_gate = (const float*)d_in[18]; p.w_up = (const float*)d_in[19]; p.w_down = (const float*)d_in[20];
    p.out = (float*)d_out; p.ws = (unsigned char*)d_ws;
#if MK_ONE_LAUNCH
    p.ph_lo = 0; p.ph_hi = PH_COUNT;
    hipLaunchKernelGGL(mk_fwd, dim3(grid), dim3(NTHR), LDS_BYTES, stream, p);
#else
    for (int ph = 0; ph < PH_COUNT; ++ph) { p.ph_lo = ph; p.ph_hi = ph + 1; hipLaunchKernelGGL(mk_fwd, dim3(grid), dim3(NTHR), LDS_BYTES, stream, p); }
#endif
}
```
